# Optimizing an MI355X kernel written in HIP

```python
import math
import jax, jax.numpy as jnp
from jax import lax
import numpy as np

D_MODEL = 1024
BATCH = 8
SEQ = 2048
DEPTH = 2

RG_WIDTH = 512
RG_BLOCKS = 4
RG_BLOCK = RG_WIDTH // RG_BLOCKS
RG_CONV = 4
RG_C = 8.0
DA_HEADS = 4
DA_HEAD_DIM = 64
DA_WIDTH = DA_HEADS * 2 * DA_HEAD_DIM
ROPE_THETA = 500000.0
ROPE_DIM = DA_HEAD_DIM // 4
Q_BLOCK = 128
NEG_INF = -1e30
ML_HEADS = 4
ML_HEAD_DIM = 128
ML_WIDTH = ML_HEADS * ML_HEAD_DIM
ML_CONV = 4
ML_CHUNK = 64
D_MIX = RG_WIDTH + DA_WIDTH + ML_WIDTH
D_FF = 2816
FFN_CONV = 3
EPS = 1e-6
IN_WIDTHS = (RG_WIDTH, RG_WIDTH, DA_WIDTH, DA_WIDTH, DA_WIDTH,
             ML_WIDTH, ML_WIDTH, ML_WIDTH, ML_WIDTH, ML_HEADS, ML_HEADS)
D_IN = sum(IN_WIDTHS)

kernel_name = 'hybrid_parallel_heads_rglru_diffattn_mlstm'


def rmsnorm(x, g):
    xf = x.astype(jnp.float32)
    y = xf * lax.rsqrt(jnp.mean(xf * xf, axis=-1, keepdims=True) + EPS)
    return (y * g.astype(jnp.float32)).astype(x.dtype)


def causal_dwconv(x, w, b):
    K = w.shape[0]
    S = x.shape[1]
    xp = jnp.pad(x, ((0, 0), (K - 1, 0), (0, 0)))
    return sum(xp[:, j:j + S] * w[j] for j in range(K)) + b


def rope_tables(positions):
    inv_freq = ROPE_THETA ** (-jnp.arange(0, ROPE_DIM, 2, dtype=jnp.float32) / ROPE_DIM)
    ang = positions.astype(jnp.float32)[..., None] * inv_freq
    return jnp.cos(ang), jnp.sin(ang)


def apply_partial_rope(x, cos, sin):
    half = ROPE_DIM // 2
    xr = x[..., :ROPE_DIM].astype(jnp.float32)
    x1, x2 = xr[..., :half], xr[..., half:]
    rot = jnp.concatenate([x1 * cos - x2 * sin, x2 * cos + x1 * sin], axis=-1)
    return jnp.concatenate([rot.astype(x.dtype), x[..., ROPE_DIM:]], axis=-1)


def rglru_group(xb, gb, conv_w, conv_b, wa, ba, wx, bx, lam, norm_g):
    B, S, _ = xb.shape
    u = causal_dwconv(xb, conv_w, conv_b)
    ub = u.reshape(B, S, RG_BLOCKS, RG_BLOCK)
    r = jax.nn.sigmoid(jnp.einsum('bsni,nij->bsnj', ub, wa).reshape(B, S, RG_WIDTH) + ba)
    i = jax.nn.sigmoid(jnp.einsum('bsni,nij->bsnj', ub, wx).reshape(B, S, RG_WIDTH) + bx)
    log_a = RG_C * r.astype(jnp.float32) * jax.nn.log_sigmoid(lam.astype(jnp.float32))
    a = jnp.exp(log_a)
    bt = jnp.sqrt(-jnp.expm1(2.0 * log_a)) * (i * u).astype(jnp.float32)

    def combine(left, right):
        a1, b1 = left
        a2, b2 = right
        return a1 * a2, a2 * b1 + b2

    _, h = lax.associative_scan(combine, (a, bt), axis=1)
    y = jax.nn.gelu(gb.astype(jnp.float32)) * h
    return rmsnorm(y.astype(xb.dtype), norm_g)


def diff_attention_group(q, k, v, positions, lam_p, norm_g, lambda_init):
    B, S, _ = q.shape
    H, dh = DA_HEADS, DA_HEAD_DIM
    q = q.reshape(B, S, H, 2, dh)
    k = k.reshape(B, S, H, 2, dh)
    v = v.reshape(B, S, H, 2 * dh)
    cos, sin = rope_tables(positions)
    cos, sin = cos[:, :, None, None, :], sin[:, :, None, None, :]
    q = apply_partial_rope(q, cos, sin)
    k = apply_partial_rope(k, cos, sin)
    lp = lam_p.astype(jnp.float32)
    lam = jnp.exp(jnp.sum(lp[0] * lp[1])) - jnp.exp(jnp.sum(lp[2] * lp[3])) + lambda_init
    nb = S // Q_BLOCK
    qb = q.reshape(B, nb, Q_BLOCK, H, 2, dh).transpose(1, 0, 2, 3, 4, 5)
    key_pos = jnp.arange(S)
    scale = dh ** -0.5

    def block(args):
        qi, bi = args
        s = jnp.einsum('bqhcd,bkhcd->bhcqk', qi, k).astype(jnp.float32) * scale
        qpos = bi * Q_BLOCK + jnp.arange(Q_BLOCK)
        mask = qpos[:, None] >= key_pos[None, :]
        p = jax.nn.softmax(jnp.where(mask, s, NEG_INF), axis=-1)
        p = p[:, :, 0] - lam * p[:, :, 1]
        return jnp.einsum('bhqk,bkhe->bqhe', p.astype(v.dtype), v)

    o = lax.map(block, (qb, jnp.arange(nb)))
    o = o.transpose(1, 0, 2, 3, 4).reshape(B, S, H, 2 * dh)
    o = rmsnorm(o, norm_g) * (1.0 - lambda_init)
    return o.reshape(B, S, DA_WIDTH)


def mlstm_chunk_step(carry, xs):
    C, n, m = carry
    qc, kc, vc, li, lf = xs
    L = qc.shape[2]
    b = jnp.cumsum(lf, axis=-1)
    causal = jnp.tril(jnp.ones((L, L), dtype=bool))
    D = jnp.where(causal, b[..., :, None] - b[..., None, :] + li[..., None, :], -jnp.inf)
    m_inter = b + m[..., None]
    m_t = jnp.maximum(m_inter, jnp.max(D, axis=-1))
    w_intra = jnp.einsum('bhtd,bhsd->bhts', qc, kc) * jnp.exp(D - m_t[..., None])
    inter = jnp.exp(m_inter - m_t)
    num = inter[..., None] * jnp.einsum('bhtd,bhde->bhte', qc, C) + jnp.einsum('bhts,bhse->bhte', w_intra, vc)
    den = inter * jnp.einsum('bhtd,bhd->bht', qc, n) + jnp.sum(w_intra, axis=-1)
    h = num / jnp.maximum(jnp.abs(den), jnp.exp(-m_t))[..., None]
    bL = b[..., -1]
    g = bL[..., None] - b + li
    m_next = jnp.maximum(bL + m, jnp.max(g, axis=-1))
    decay = jnp.exp(bL + m - m_next)
    wk = jnp.exp(g - m_next[..., None])
    C_new = decay[..., None, None] * C + jnp.einsum('bhs,bhsd,bhse->bhde', wk, kc, vc)
    n_new = decay[..., None] * n + jnp.einsum('bhs,bhsd->bhd', wk, kc)
    return (C_new, n_new, m_next), h


def mlstm_group(q, k, v, o_pre, i_pre, f_pre, conv_w, conv_b, i_bias, f_bias, norm_g):
    B, S, _ = q.shape
    H, dh = ML_HEADS, ML_HEAD_DIM
    qk = jax.nn.silu(causal_dwconv(jnp.concatenate([q, k], axis=-1), conv_w, conv_b))
    q, k = qk[..., :ML_WIDTH], qk[..., ML_WIDTH:]
    qh = q.reshape(B, S, H, dh).astype(jnp.float32)
    kh = k.reshape(B, S, H, dh).astype(jnp.float32) * (dh ** -0.5)
    vh = v.reshape(B, S, H, dh).astype(jnp.float32)
    log_i = (i_pre + i_bias).astype(jnp.float32)
    log_f = jax.nn.log_sigmoid((f_pre + f_bias).astype(jnp.float32))
    nc = S // ML_CHUNK

    def chunks4(t):
        return t.reshape(B, nc, ML_CHUNK, H, dh).transpose(1, 0, 3, 2, 4)

    def chunks3(t):
        return t.reshape(B, nc, ML_CHUNK, H).transpose(1, 0, 3, 2)

    init = (jnp.zeros((B, H, dh, dh), jnp.float32), jnp.zeros((B, H, dh), jnp.float32),
            jnp.zeros((B, H), jnp.float32))
    _, h = lax.scan(mlstm_chunk_step, init,
                    (chunks4(qh), chunks4(kh), chunks4(vh), chunks3(log_i), chunks3(log_f)))
    h = h.transpose(1, 0, 3, 2, 4).reshape(B, S, H, dh).astype(q.dtype)
    h = rmsnorm(h, norm_g.reshape(H, dh)).reshape(B, S, ML_WIDTH)
    return h * jax.nn.sigmoid(o_pre)


def conv_gated_mlp(x, w_up, conv_w, conv_b, w_down):
    u = causal_dwconv(x @ w_up, conv_w, conv_b)
    g, val = u[..., :D_FF], u[..., D_FF:]
    return (jax.nn.silu(g) * val) @ w_down


def setup_inputs(seed: int = 0) -> dict:
    key = jax.random.key(seed)
    ks = iter(jax.random.split(key, 40))
    f32 = jnp.float32

    def nrm(shape, scale):
        return jax.random.normal(next(ks), shape, f32) * scale

    def gain(shape):
        return 1.0 + nrm(shape, 0.02)

    x = jax.random.normal(next(ks), (BATCH, SEQ, D_MODEL), f32)
    offset = jax.random.randint(next(ks), (BATCH, 1), 0, 1024, dtype=jnp.int32)
    positions = offset + jnp.arange(SEQ, dtype=jnp.int32)[None, :]
    u = jax.random.uniform(next(ks), (DEPTH, RG_WIDTH), f32, 0.9, 0.999) ** (1.0 / RG_C)
    rg_lambda = jnp.log(u) - jnp.log1p(-u)
    ml_f_bias = jnp.linspace(3.0, 6.0, ML_HEADS, dtype=f32)[None, :] + nrm((DEPTH, ML_HEADS), 0.1)
    return {
        'x': x,
        'positions': positions,
        'attn_norm': gain((DEPTH, D_MODEL)),
        'w_in': nrm((DEPTH, D_MODEL, D_IN), D_MODEL ** -0.5),
        'rg_conv_w': nrm((DEPTH, RG_CONV, RG_WIDTH), RG_CONV ** -0.5),
        'rg_conv_b': nrm((DEPTH, RG_WIDTH), 0.01),
        'rg_wa': nrm((DEPTH, RG_BLOCKS, RG_BLOCK, RG_BLOCK), RG_BLOCK ** -0.5),
        'rg_ba': nrm((DEPTH, RG_WIDTH), 0.01),
        'rg_wx': nrm((DEPTH, RG_BLOCKS, RG_BLOCK, RG_BLOCK), RG_BLOCK ** -0.5),
        'rg_bx': nrm((DEPTH, RG_WIDTH), 0.01),
        'rg_lambda': rg_lambda,
        'rg_norm': gain((DEPTH, RG_WIDTH)),
        'da_lambda': nrm((DEPTH, 4, DA_HEAD_DIM), 0.1),
        'da_norm': gain((DEPTH, 2 * DA_HEAD_DIM)),
        'ml_conv_w': nrm((DEPTH, ML_CONV, 2 * ML_WIDTH), ML_CONV ** -0.5),
        'ml_conv_b': nrm((DEPTH, 2 * ML_WIDTH), 0.01),
        'ml_i_bias': nrm((DEPTH, ML_HEADS), 0.1),
        'ml_f_bias': ml_f_bias,
        'ml_norm': gain((DEPTH, ML_WIDTH)),
        'w_out': nrm((DEPTH, D_MIX, D_MODEL), D_MIX ** -0.5),
        'mlp_norm': gain((DEPTH, D_MODEL)),
        'w_up': nrm((DEPTH, D_MODEL, 2 * D_FF), D_MODEL ** -0.5),
        'ffn_conv_w': nrm((DEPTH, FFN_CONV, 2 * D_FF), FFN_CONV ** -0.5),
        'ffn_conv_b': nrm((DEPTH, 2 * D_FF), 0.01),
        'w_down': nrm((DEPTH, D_FF, D_MODEL), D_FF ** -0.5),
        'final_norm': gain((D_MODEL,)),
    }


def reference(x, positions, attn_norm, w_in, rg_conv_w, rg_conv_b, rg_wa, rg_ba, rg_wx, rg_bx,
              rg_lambda, rg_norm, da_lambda, da_norm, ml_conv_w, ml_conv_b, ml_i_bias, ml_f_bias,
              ml_norm, w_out, mlp_norm, w_up, ffn_conv_w, ffn_conv_b, w_down, final_norm):
    cuts = np.cumsum(IN_WIDTHS)[:-1].tolist()
    for l in range(DEPTH):
        lambda_init = 0.8 - 0.6 * math.exp(-0.3 * l)
        h = rmsnorm(x, attn_norm[l])
        z = h @ w_in[l]
        rg_x, rg_g, da_q, da_k, da_v, ml_q, ml_k, ml_v, ml_o, ml_i, ml_f = jnp.split(z, cuts, axis=-1)
        y_rg = rglru_group(rg_x, rg_g, rg_conv_w[l], rg_conv_b[l], rg_wa[l], rg_ba[l], rg_wx[l],
                           rg_bx[l], rg_lambda[l], rg_norm[l])
        y_da = diff_attention_group(da_q, da_k, da_v, positions, da_lambda[l], da_norm[l], lambda_init)
        y_ml = mlstm_group(ml_q, ml_k, ml_v, ml_o, ml_i, ml_f, ml_conv_w[l], ml_conv_b[l],
                           ml_i_bias[l], ml_f_bias[l], ml_norm[l])
        x = x + jnp.concatenate([y_rg, y_da, y_ml], axis=-1) @ w_out[l]
        h = rmsnorm(x, mlp_norm[l])
        x = x + conv_gated_mlp(h, w_up[l], ffn_conv_w[l], ffn_conv_b[l], w_down[l])
    return rmsnorm(x, final_norm)
```

```cpp
#include <hip/hip_runtime.h>
#include <hip/hip_cooperative_groups.h>
#include <hip/hip_bf16.h>
#include <cstdio>
#include <cstdint>
#include <cmath>
namespace pg8 {
#define PG8_LAS __attribute__((address_space(3)))
typedef unsigned short bf16_t;
typedef short bf16x8 __attribute__((ext_vector_type(8)));
typedef float f32x4 __attribute__((ext_vector_type(4)));
typedef unsigned u32x4 __attribute__((ext_vector_type(4)));
constexpr int BM = 256, BK = 64, HALF = 128, HTB = HALF * BK * 2  , STAGE_BYTES = 8 * HTB, NXCD = 8, WGM = 8;

__host__ __device__ __forceinline__ int lds_byte(int r, int c) { const int st = (r >> 4) * 2 + (c >> 5), rr = r & 15, cc = c & 31, ob = rr * 64 + cc * 2; return st * 1024 + (ob ^ (((ob >> 9) & 1) << 5)); }
__host__ __device__ __forceinline__ void stage_rc(int b, int& R, int& C) { const int st = b / 1024, sb = b % 1024, swz = sb ^ (((sb >> 9) & 1) << 5); R = (st >> 1) * 16 + swz / 64; C = (st & 1) * 32 + (swz % 64) / 2; }
__host__ __device__ __forceinline__ int perm32(int rho) { const int n = rho >> 4, i = rho & 15; return 8 * (i >> 2) + 4 * n + (i & 3); }

struct Unit { int pm, pn; };
struct Gemm { const bf16_t* A; const bf16_t* Bt; int M, N, K, lda; };

struct StaticOrder {
    int nM, nN, nwg, G, c;
    __host__ __device__ void init(int M, int N, int G_, int c_) { nM = M / BM; nN = N / BM; nwg = nM * nN; G = G_; c = c_; }
    __host__ __device__ bool next(int i, Unit& u) const {
        const long L = (long)i * G + c; if (L >= nwg) return false;
        int wgid = (int)L; { const int q = nwg / NXCD, r = nwg % NXCD, xcd = wgid % NXCD, off = wgid / NXCD; wgid = (xcd < r ? xcd * (q + 1) : r * (q + 1) + (xcd - r) * q) + off; }
        const int nig = WGM * nN, gid = wgid / nig, fm = gid * WGM, gsz = (nM - fm) < WGM ? (nM - fm) : WGM;
        u.pm = fm + ((wgid % nig) % gsz); u.pn = (wgid % nig) / gsz; return true;
    }
    __device__ __forceinline__ void a_ready(const Unit&) const {}
    __device__ __forceinline__ void done(const Unit&) const {}
};

__device__ __forceinline__ unsigned cvt_pk_bf16(float lo, float hi) { unsigned r; asm volatile("v_cvt_pk_bf16_f32 %0, %1, %2" : "=v"(r) : "v"(lo), "v"(hi)); return r; }
typedef float f32x2 __attribute__((ext_vector_type(2)));

constexpr float QSCALE = 0.125f * 1.4426950408889634f;
constexpr int ZP = 4608, UP = 5632;
__device__ __forceinline__ u32x4 pack8(const f32x4 v0, const f32x4 v1) { u32x4 w; w.x = cvt_pk_bf16(v0[0], v0[1]); w.y = cvt_pk_bf16(v0[2], v0[3]); w.z = cvt_pk_bf16(v1[0], v1[1]); w.w = cvt_pk_bf16(v1[2], v1[3]); return w; }
struct EpiZ {
    static constexpr bool PERM = true, AFTER_DRAIN = false;
    bf16_t* Z; const float* rstd; const float* rope; bf16_t* zhalo; float* gates;
    __device__ __forceinline__ void operator()(const f32x4 (&acc)[2][2][4][2], const Unit& u, int wr, int wc, int fr, int fq) const {
        const int row0 = u.pm * BM + wr * 64 + fr, col0 = u.pn * BM + wc * 32 + 8 * fq;
        const bool isq = (u.pn == 4 || u.pn == 5), isk = (u.pn == 8 || u.pn == 9);
        const bool dorope = (isq || isk) && ((wc & 1) == 0);
        const float sc = isq ? QSCALE : 1.f;
        const int hblk = (u.pn < 2) ? 0 : (u.pn == 12 || u.pn == 13) ? 1 : (u.pn == 14 || u.pn == 15) ? 2 : -1;
        float rsv[2][4];
#pragma unroll
        for (int ai = 0; ai < 2; ++ai)
#pragma unroll
            for (int m = 0; m < 4; ++m) rsv[ai][m] = rstd[row0 + ai * HALF + m * 16];
        f32x4 rpn[4];
        if (dorope) { const f32x4* rp = (const f32x4*)(rope + (size_t)row0 * 16);
#pragma unroll
            for (int q = 0; q < 4; ++q) rpn[q] = rp[q]; }
#pragma unroll
        for (int ai = 0; ai < 2; ++ai) {
#pragma unroll
            for (int m = 0; m < 4; ++m) {
                const int row = row0 + ai * HALF + m * 16;
                f32x4 rpc[4];
                if (dorope) {
#pragma unroll
                    for (int q = 0; q < 4; ++q) rpc[q] = rpn[q];
                    if (ai * 4 + m < 7) { const int nrow = row0 + ((ai * 4 + m + 1) >> 2) * HALF + ((ai * 4 + m + 1) & 3) * 16; const f32x4* rp = (const f32x4*)(rope + (size_t)nrow * 16);
#pragma unroll
                        for (int q = 0; q < 4; ++q) rpn[q] = rp[q]; }
                }
                const float rs = sc * __builtin_amdgcn_rsqf(rsv[ai][m] * (1.f / 1024.f) + 1e-6f);
                f32x4 v[2][2];
#pragma unroll
                for (int bj = 0; bj < 2; ++bj)
#pragma unroll
                    for (int n = 0; n < 2; ++n) v[bj][n] = acc[ai][bj][m][n] * rs;
                if (dorope) {
                    const f32x4 c0 = rpc[0], c1 = rpc[1], s0 = rpc[2], s1 = rpc[3];
#pragma unroll
                    for (int bj = 0; bj < 2; ++bj) {
                        f32x4 p0, p1;
#pragma unroll
                        for (int i = 0; i < 4; ++i) { p0[i] = __shfl_xor(v[bj][0][i], 16); p1[i] = __shfl_xor(v[bj][1][i], 16); }
                        if (fq == 0) { v[bj][0] = v[bj][0] * c0 - p0 * s0; v[bj][1] = v[bj][1] * c1 - p1 * s1; }
                        else if (fq == 1) { v[bj][0] = v[bj][0] * c0 + p0 * s0; v[bj][1] = v[bj][1] * c1 + p1 * s1; }
                    }
                }
                if (u.pn == 18) { if (wc == 0 && fq == 0) { *(f32x4*)(gates + (size_t)row * 8) = v[0][0]; *(f32x4*)(gates + (size_t)row * 8 + 4) = v[0][1]; } continue; }
                bf16_t* rowp = Z + (size_t)row * ZP + col0;
#pragma unroll
                for (int bj = 0; bj < 2; ++bj) { const u32x4 w = pack8(v[bj][0], v[bj][1]); *(u32x4*)(rowp + bj * HALF) = w;
                    if (hblk >= 0 && m == 3 && fr >= 13) *(u32x4*)(zhalo + ((size_t)(row >> 6) * 3 + (fr - 13)) * 1536 + hblk * 512 + (u.pn & 1) * 256 + wc * 32 + 8 * fq + bj * HALF) = w; }
            }
        }
    }
};
struct EpiU {
    static constexpr bool PERM = true, AFTER_DRAIN = false;
    bf16_t* U; const float* rstd; bf16_t* halo;
    __device__ __forceinline__ void operator()(const f32x4 (&acc)[2][2][4][2], const Unit& u, int wr, int wc, int fr, int fq) const {
        const int row0 = u.pm * BM + wr * 64 + fr, col0 = u.pn * BM + wc * 32 + 8 * fq;
#pragma unroll
        for (int ai = 0; ai < 2; ++ai)
#pragma unroll
            for (int m = 0; m < 4; ++m) {
                const int row = row0 + ai * HALF + m * 16;
                const float rs = rstd[row];
                bf16_t* rowp = U + (size_t)row * UP + col0;
#pragma unroll
                for (int bj = 0; bj < 2; ++bj) {
                    const u32x4 w = pack8(acc[ai][bj][m][0] * rs, acc[ai][bj][m][1] * rs);
                    *(u32x4*)(rowp + bj * HALF) = w;
                    if (m == 3 && fr >= 14) *(u32x4*)(halo + ((size_t)(row >> 6) * 2 + (fr - 14)) * UP + col0 + bj * HALF) = w;
                }
            }
    }
};
struct EpiRes {
    static constexpr bool PERM = false, AFTER_DRAIN = false;
    const float* base; float* out;
    __device__ __forceinline__ void operator()(const f32x4 (&acc)[2][2][4][2], const Unit& u, int wr, int wc, int fr, int fq) const {
        const int col0 = u.pn * BM + wc * 32 + 4 * fq;
#pragma unroll
        for (int ai = 0; ai < 2; ++ai)
#pragma unroll
            for (int m = 0; m < 4; ++m) {
                const size_t off = (size_t)(u.pm * BM + ai * HALF + wr * 64 + m * 16 + fr) * 1024 + col0;
#pragma unroll
                for (int bj = 0; bj < 2; ++bj)
#pragma unroll
                    for (int n = 0; n < 2; ++n) { const f32x4 bs = *(const f32x4*)(base + off + bj * HALF + n * 16); *(f32x4*)(out + off + bj * HALF + n * 16) = bs + acc[ai][bj][m][n]; }
            }
    }
};

template <int CTRL> __device__ __forceinline__ float dppf_(float v) { return __int_as_float(__builtin_amdgcn_update_dpp(0, __float_as_int(v), CTRL, 0xf, 0xf, true)); }
#define DPPF(v, CTRL) dppf_<CTRL>(v)
struct EpiUG {
    static constexpr bool PERM = true, AFTER_DRAIN = false;
    bf16_t* H; const float* rstd; bf16_t* halo; bf16_t* uhead; const float* cw; const float* cb;
    __device__ __forceinline__ void operator()(const f32x4 (&acc)[2][2][4][2], const Unit& u, int wr, int wc, int fr, int fq) const {
        constexpr int DFF_ = 2816;
        const int ch0 = u.pn * 128 + wc * 32 + 8 * fq;
#pragma unroll
        for (int n = 0; n < 2; ++n) {
            const int ch = ch0 + 4 * n;
            const f32x4 wg0 = *(const f32x4*)(cw + ch), wg1 = *(const f32x4*)(cw + UP + ch), wg2 = *(const f32x4*)(cw + 2 * UP + ch), bg = *(const f32x4*)(cb + ch);
            const f32x4 wv0 = *(const f32x4*)(cw + DFF_ + ch), wv1 = *(const f32x4*)(cw + UP + DFF_ + ch), wv2 = *(const f32x4*)(cw + 2 * UP + DFF_ + ch), bv = *(const f32x4*)(cb + DFF_ + ch);
#pragma unroll
            for (int ai = 0; ai < 2; ++ai) {
                f32x4 pg = (f32x4){0.f, 0.f, 0.f, 0.f}, pv = pg;
                float rs4[4];
#pragma unroll
                for (int m = 0; m < 4; ++m) rs4[m] = rstd[u.pm * BM + ai * HALF + wr * 64 + m * 16 + fr];
#pragma unroll
                for (int m = 0; m < 4; ++m) {
                    const int row = u.pm * BM + ai * HALF + wr * 64 + m * 16 + fr;
                    const float rs = __builtin_amdgcn_rsqf(rs4[m] * (1.f / 1024.f) + 1e-6f);
                    const f32x4 g = acc[ai][0][m][n] * rs, v = acc[ai][1][m][n] * rs;
                    f32x4 g1, g2, v1, v2;
#pragma unroll
                    for (int i = 0; i < 4; ++i) {
                        g1[i] = DPPF(g[i], 0x111) + DPPF(pg[i], 0x10F); g2[i] = DPPF(g[i], 0x112) + DPPF(pg[i], 0x10E);
                        v1[i] = DPPF(v[i], 0x111) + DPPF(pv[i], 0x10F); v2[i] = DPPF(v[i], 0x112) + DPPF(pv[i], 0x10E);
                    }
                    const f32x4 cg = wg0 * g2 + wg1 * g1 + wg2 * g + bg, cv = wv0 * v2 + wv1 * v1 + wv2 * v + bv;
                    float hd[4];
#pragma unroll
                    for (int i = 0; i < 4; ++i) hd[i] = cg[i] * __builtin_amdgcn_rcpf(1.f + __expf(-cg[i])) * cv[i];
                    typedef unsigned u32x2_ __attribute__((ext_vector_type(2)));
                    u32x2_ w; w.x = cvt_pk_bf16(hd[0], hd[1]); w.y = cvt_pk_bf16(hd[2], hd[3]);
                    *(u32x2_*)(H + (size_t)row * DFF_ + ch) = w;
                    if ((m == 3 && fr >= 14) || (m == 0 && fr < 2)) {
                        u32x2_ rg, rv; rg.x = cvt_pk_bf16(g[0], g[1]); rg.y = cvt_pk_bf16(g[2], g[3]); rv.x = cvt_pk_bf16(v[0], v[1]); rv.y = cvt_pk_bf16(v[2], v[3]);
                        bf16_t* dst = (m == 3) ? halo + ((size_t)(row >> 6) * 2 + (fr - 14)) * UP : uhead + ((size_t)(row >> 6) * 2 + fr) * UP;
                        *(u32x2_*)(dst + ch) = rg; *(u32x2_*)(dst + DFF_ + ch) = rv;
                    }
                    pg = g; pv = v;
                }
            }
        }
    }
};

template <bool LAST> struct EpiResN_ {
    static constexpr bool PERM = false, AFTER_DRAIN = false;
    const float* base; float* out; bf16_t* xb; float* ssq;
    __device__ __forceinline__ void operator()(const f32x4 (&acc)[2][2][4][2], const Unit& u, int wr, int wc, int fr, int fq) const {
        typedef unsigned u32x2_ __attribute__((ext_vector_type(2)));
        const int col0 = u.pn * BM + wc * 32 + 4 * fq;
#pragma unroll
        for (int ai = 0; ai < 2; ++ai) {
            f32x4 pre[4][2][2];
#pragma unroll
            for (int m = 0; m < 4; ++m) { const size_t off = (size_t)(u.pm * BM + ai * HALF + wr * 64 + m * 16 + fr) * 1024 + col0;
#pragma unroll
                for (int bj = 0; bj < 2; ++bj)
#pragma unroll
                    for (int n = 0; n < 2; ++n) pre[m][bj][n] = *(const f32x4*)(base + off + bj * HALF + n * 16); }
            asm volatile("" ::: "memory");
#pragma unroll
            for (int m = 0; m < 4; ++m) {
                const int row = u.pm * BM + ai * HALF + wr * 64 + m * 16 + fr;
                const size_t off = (size_t)row * 1024 + col0; float ss = 0.f;
#pragma unroll
                for (int bj = 0; bj < 2; ++bj)
#pragma unroll
                    for (int n = 0; n < 2; ++n) { const f32x4 v = pre[m][bj][n] + acc[ai][bj][m][n]; *(f32x4*)(out + off + bj * HALF + n * 16) = v;
                        if (!LAST) { u32x2_ w; w.x = cvt_pk_bf16(v[0], v[1]); w.y = cvt_pk_bf16(v[2], v[3]); *(u32x2_*)(xb + off + bj * HALF + n * 16) = w;
                            ss += (v[0] * v[0] + v[1] * v[1]) + (v[2] * v[2] + v[3] * v[3]); } }
                if (!LAST) { ss += __shfl_xor(ss, 16); ss += __shfl_xor(ss, 32);
                    if (fq == 0) __hip_atomic_fetch_add(ssq + row, ss, __ATOMIC_RELAXED, __HIP_MEMORY_SCOPE_AGENT); }
            }
        }
    }
};
typedef EpiResN_<false> EpiResN;
typedef EpiResN_<true> EpiResL;

struct EpiResFinal {
    static constexpr bool PERM = false, AFTER_DRAIN = true;
    const float* base; float* out; float* ssq; unsigned* cnt; const float* gain;
    __device__ __forceinline__ void fused(f32x4 (&acc)[2][2][4][2], const Unit& u, int wr, int wc, int fr, int fq, PG8_LAS unsigned char* lds, int wid, int lane) const {
        const int col0 = u.pn * BM + wc * 32 + 4 * fq;
#pragma unroll
        for (int ai = 0; ai < 2; ++ai)
#pragma unroll
            for (int m = 0; m < 4; ++m) {
                const int row = u.pm * BM + ai * HALF + wr * 64 + m * 16 + fr;
                const size_t off = (size_t)row * 1024 + col0; float ss = 0.f;
#pragma unroll
                for (int bj = 0; bj < 2; ++bj)
#pragma unroll
                    for (int n = 0; n < 2; ++n) { const f32x4 v = *(const f32x4*)(base + off + bj * HALF + n * 16) + acc[ai][bj][m][n]; acc[ai][bj][m][n] = v;
                        ss += (v[0] * v[0] + v[1] * v[1]) + (v[2] * v[2] + v[3] * v[3]); }
                ss += __shfl_xor(ss, 16); ss += __shfl_xor(ss, 32);
                if (fq == 0) __hip_atomic_fetch_add(ssq + row, ss, __ATOMIC_RELAXED, __HIP_MEMORY_SCOPE_AGENT);
            }
        asm volatile("s_waitcnt vmcnt(0)" ::: "memory");
        __builtin_amdgcn_fence(__ATOMIC_RELEASE, "agent");
        if (lane == 0) __hip_atomic_fetch_add(cnt + 64 * u.pm, 1u, __ATOMIC_RELAXED, __HIP_MEMORY_SCOPE_AGENT);
        if (wid == 0) { unsigned sp = 0;
            while (__hip_atomic_load(cnt + 64 * u.pm, __ATOMIC_RELAXED, __HIP_MEMORY_SCOPE_AGENT) < 32u && ++sp < (1u << 22)) __builtin_amdgcn_s_sleep(2); }
        asm volatile("s_waitcnt vmcnt(0) lgkmcnt(0)" ::: "memory"); __builtin_amdgcn_s_barrier(); asm volatile("" ::: "memory");
        __builtin_amdgcn_fence(__ATOMIC_ACQUIRE, "agent");
        f32x4 gv[2][2];
#pragma unroll
        for (int bj = 0; bj < 2; ++bj)
#pragma unroll
            for (int n = 0; n < 2; ++n) gv[bj][n] = *(const f32x4*)(gain + col0 + bj * HALF + n * 16);
#pragma unroll
        for (int ai = 0; ai < 2; ++ai)
#pragma unroll
            for (int m = 0; m < 4; ++m) {
                const int row = u.pm * BM + ai * HALF + wr * 64 + m * 16 + fr;
                const size_t off = (size_t)row * 1024 + col0;
                const float r = __builtin_amdgcn_rsqf(__hip_atomic_load(ssq + row, __ATOMIC_RELAXED, __HIP_MEMORY_SCOPE_AGENT) * (1.f / 1024.f) + 1e-6f);
#pragma unroll
                for (int bj = 0; bj < 2; ++bj)
#pragma unroll
                    for (int n = 0; n < 2; ++n) *(f32x4*)(out + off + bj * HALF + n * 16) = acc[ai][bj][m][n] * r * gv[bj][n];
            }
    }
};
template <class Epi, class Sched, bool ALIGN_EPI = false, bool SP2 = false>
__device__ __forceinline__ void gemm_phase(PG8_LAS unsigned char* lds, const Gemm g, const Sched& S, const Epi& E) {
    int tid = threadIdx.x; asm volatile("" : "+v"(tid)); const int wid = __builtin_amdgcn_readfirstlane(tid >> 6), lane = tid & 63, wr = wid >> 2, wc = wid & 3, fr = lane & 15, fq = lane >> 4;
    const int K = g.K, nt = K / BK;
    unsigned voffA[2], voffB[2];
#pragma unroll
    for (int i = 0; i < 2; ++i) { int R, C; stage_rc(tid * 16 + i * 8192, R, C); const int Rb = Epi::PERM ? ((R & ~31) + perm32(R & 31)) : R;
        voffA[i] = (unsigned)(R * g.lda + C) * 2u; voffB[i] = (unsigned)(Rb * K + C) * 2u; }
    const size_t kstep = (size_t)(BK * 2);
    const size_t hstepB = (size_t)HALF * K * 2, hstepA = (size_t)HALF * g.lda * 2;
    const size_t tstepA = 2 * hstepA, tstepB = 2 * hstepB;
    const unsigned ldsw = (unsigned)wid * 1024u;
    const int aoff = lds_byte(wr * 64 + fr, fq * 8), boff = lds_byte(wc * 32 + fr, fq * 8);
#define PG8_SA(b, h) (((b) * 2 + (h)) * HTB)
#define PG8_SB(b, h) ((4 + (b) * 2 + (h)) * HTB)
#define PG8_STAGE(bufoff, gbase, voff) do { _Pragma("unroll") for (int _i = 0; _i < 2; ++_i) \
        __builtin_amdgcn_global_load_lds((const unsigned*)((const char*)(gbase) + (voff)[_i]), (PG8_LAS unsigned*)(lds + (bufoff) + ldsw + _i * 8192), 16, 0, 0); } while (0)
#define PG8_LDA(dst, b, h) do { _Pragma("unroll") for (int m = 0; m < 4; ++m) _Pragma("unroll") for (int k = 0; k < 2; ++k) dst[m][k] = *(const PG8_LAS bf16x8*)(lds + PG8_SA(b, h) + aoff + m * 2048 + k * 1024); } while (0)
#define PG8_LDB(dst, b, h) do { _Pragma("unroll") for (int n = 0; n < 2; ++n) _Pragma("unroll") for (int k = 0; k < 2; ++k) dst[n][k] = *(const PG8_LAS bf16x8*)(lds + PG8_SB(b, h) + boff + n * 2048 + k * 1024); } while (0)
#define PG8_MMA(ai, bj, At, Bt) do { __builtin_amdgcn_s_setprio(1); _Pragma("unroll") for (int m = 0; m < 4; ++m) _Pragma("unroll") for (int n = 0; n < 2; ++n) _Pragma("unroll") for (int k = 0; k < 2; ++k) \
        acc[ai][bj][m][n] = __builtin_amdgcn_mfma_f32_16x16x32_bf16(Bt[n][k], At[m][k], acc[ai][bj][m][n], 0, 0, 0); __builtin_amdgcn_s_setprio(0); } while (0)
#define PG8_WAIT_V(n) asm volatile("s_waitcnt vmcnt(" #n ")" ::: "memory")
#define PG8_WAIT_L(n) asm volatile("s_waitcnt lgkmcnt(" #n ")" ::: "memory")
#define PG8_BAR __builtin_amdgcn_s_barrier()
#define PG8_SCHED __builtin_amdgcn_sched_barrier(0)
    Unit cur, nxt; int ui = 0;
    if (!S.next(0, cur)) return;
    f32x4 acc[2][2][4][2];
#pragma unroll
    for (int a = 0; a < 2; ++a)
#pragma unroll
        for (int b = 0; b < 2; ++b)
#pragma unroll
            for (int m = 0; m < 4; ++m)
#pragma unroll
                for (int n = 0; n < 2; ++n) acc[a][b][m][n] = (f32x4){0.f, 0.f, 0.f, 0.f};
    bf16x8 At[4][2], B0[2][2], B1[2][2];
    const char* cA = (const char*)g.A + (size_t)cur.pm * tstepA; const char* cB = (const char*)g.Bt + (size_t)cur.pn * tstepB;
    S.a_ready(cur);
    if constexpr (SP2) {
        PG8_STAGE(PG8_SB(0, 0), cB, voffB); PG8_STAGE(PG8_SB(0, 1), cB + hstepB, voffB); PG8_STAGE(PG8_SA(0, 0), cA, voffA); PG8_STAGE(PG8_SA(0, 1), cA + hstepA, voffA);
        if (wr == 1) PG8_BAR;
        PG8_WAIT_V(2); PG8_BAR;
        PG8_STAGE(PG8_SB(1, 0), cB + kstep, voffB); PG8_STAGE(PG8_SA(1, 0), cA + kstep, voffA); PG8_STAGE(PG8_SB(1, 1), cB + hstepB + kstep, voffB);
        PG8_WAIT_V(6); PG8_BAR;
    } else {
        PG8_STAGE(PG8_SB(0, 0), cB, voffB); PG8_STAGE(PG8_SA(0, 0), cA, voffA); PG8_STAGE(PG8_SB(0, 1), cB + hstepB, voffB); PG8_STAGE(PG8_SA(0, 1), cA + hstepA, voffA);
        if (wr == 1) PG8_BAR;
        PG8_WAIT_V(4); PG8_BAR;
        PG8_STAGE(PG8_SB(1, 0), cB + kstep, voffB); PG8_STAGE(PG8_SA(1, 0), cA + kstep, voffA); PG8_STAGE(PG8_SB(1, 1), cB + hstepB + kstep, voffB);
        PG8_WAIT_V(6); PG8_BAR;
    }
    for (;;) {
        const bool has_next = S.next(ui + 1, nxt);
        const char* nA = has_next ? (const char*)g.A + (size_t)nxt.pm * tstepA : cA; const char* nB = has_next ? (const char*)g.Bt + (size_t)nxt.pn * tstepB : cB;
        for (int t = 0; t < nt; t += 2) {
            const bool last = (t == nt - 2);
            const char* a1 = cA + (size_t)(t + 1) * kstep;
            const char* a2 = last ? nA : cA + (size_t)(t + 2) * kstep; const char* b2 = last ? nB : cB + (size_t)(t + 2) * kstep;
            const char* a3 = a2 + kstep; const char* b3 = b2 + kstep;
            if (last && has_next) S.a_ready(nxt);
            if constexpr (SP2) {
            PG8_LDB(B0, 0, 0); PG8_LDB(B1, 0, 1); PG8_SCHED; PG8_LDA(At, 0, 0); PG8_STAGE(PG8_SA(1, 1), a1 + hstepA, voffA);
            PG8_WAIT_V(8); PG8_WAIT_L(0); PG8_BAR; PG8_MMA(0, 0, At, B0); PG8_MMA(0, 1, At, B1); PG8_BAR; PG8_SCHED;
            PG8_LDA(At, 0, 1); PG8_STAGE(PG8_SB(0, 0), b2, voffB); PG8_STAGE(PG8_SB(0, 1), b2 + hstepB, voffB); PG8_STAGE(PG8_SA(0, 0), a2, voffA);
            PG8_WAIT_V(8); PG8_WAIT_L(0); PG8_BAR; PG8_MMA(1, 0, At, B0); PG8_MMA(1, 1, At, B1); PG8_BAR; PG8_SCHED;
            PG8_LDB(B0, 1, 0); PG8_LDB(B1, 1, 1); PG8_SCHED; PG8_LDA(At, 1, 0); PG8_STAGE(PG8_SA(0, 1), a2 + hstepA, voffA);
            PG8_WAIT_V(8); PG8_WAIT_L(0); PG8_BAR; PG8_MMA(0, 0, At, B0); PG8_MMA(0, 1, At, B1); PG8_BAR; PG8_SCHED;
            PG8_LDA(At, 1, 1); PG8_STAGE(PG8_SB(1, 0), b3, voffB); PG8_STAGE(PG8_SB(1, 1), b3 + hstepB, voffB); PG8_STAGE(PG8_SA(1, 0), a3, voffA);
            PG8_WAIT_V(8); PG8_WAIT_L(0); PG8_BAR; PG8_MMA(1, 0, At, B0); PG8_MMA(1, 1, At, B1); PG8_BAR; PG8_SCHED;
            } else {
            PG8_LDB(B0, 0, 0); PG8_SCHED; PG8_LDA(At, 0, 0); PG8_STAGE(PG8_SA(1, 1), a1 + hstepA, voffA);
            PG8_WAIT_L(8); PG8_BAR; PG8_WAIT_L(0); PG8_MMA(0, 0, At, B0); PG8_BAR; PG8_SCHED;
            PG8_LDB(B1, 0, 1); PG8_STAGE(PG8_SB(0, 0), b2, voffB);
            PG8_BAR; PG8_WAIT_L(0); PG8_MMA(0, 1, At, B1); PG8_BAR;
            PG8_LDA(At, 0, 1); PG8_STAGE(PG8_SA(0, 0), a2, voffA);
            PG8_BAR; PG8_WAIT_L(0); PG8_MMA(1, 0, At, B0); PG8_BAR; PG8_SCHED;
            PG8_STAGE(PG8_SB(0, 1), b2 + hstepB, voffB);
            PG8_WAIT_V(6); PG8_BAR; PG8_MMA(1, 1, At, B1); PG8_BAR;
            PG8_LDB(B0, 1, 0); PG8_SCHED; PG8_LDA(At, 1, 0); PG8_STAGE(PG8_SA(0, 1), a2 + hstepA, voffA);
            PG8_WAIT_L(8); PG8_BAR; PG8_WAIT_L(0); PG8_MMA(0, 0, At, B0); PG8_BAR; PG8_SCHED;
            PG8_LDB(B1, 1, 1); PG8_STAGE(PG8_SB(1, 0), b3, voffB);
            PG8_BAR; PG8_WAIT_L(0); PG8_MMA(0, 1, At, B1); PG8_BAR;
            PG8_LDA(At, 1, 1); PG8_STAGE(PG8_SA(1, 0), a3, voffA);
            PG8_BAR; PG8_WAIT_L(0); PG8_MMA(1, 0, At, B0); PG8_BAR; PG8_SCHED;
            PG8_STAGE(PG8_SB(1, 1), b3 + hstepB, voffB);
            PG8_WAIT_V(6); PG8_BAR; PG8_MMA(1, 1, At, B1); PG8_BAR;
            }
        }
        if constexpr (ALIGN_EPI) { if (wr == 0) PG8_BAR; }
        if constexpr (!Epi::AFTER_DRAIN) { E(acc, cur, wr, wc, fr, fq); S.done(cur); }
        if (!has_next) break;
#pragma unroll
        for (int a = 0; a < 2; ++a)
#pragma unroll
            for (int b = 0; b < 2; ++b)
#pragma unroll
                for (int m = 0; m < 4; ++m)
#pragma unroll
                    for (int n = 0; n < 2; ++n) acc[a][b][m][n] = (f32x4){0.f, 0.f, 0.f, 0.f};
        cur = nxt; cA = nA; cB = nB; ++ui;
        if constexpr (ALIGN_EPI) { if (wr == 1) PG8_BAR; }
    }
    PG8_WAIT_V(0);
    if constexpr (!ALIGN_EPI) { if (wr == 0) PG8_BAR; }
    PG8_BAR;
    if constexpr (Epi::AFTER_DRAIN) { E.fused(acc, cur, wr, wc, fr, fq, lds, wid, lane); S.done(cur); }
#undef PG8_SA
#undef PG8_SB
#undef PG8_STAGE
#undef PG8_LDA
#undef PG8_LDB
#undef PG8_MMA
#undef PG8_WAIT_V
#undef PG8_WAIT_L
#undef PG8_BAR
#undef PG8_SCHED
}
}
#include <hip/hip_bf16.h>
#include <cmath>
namespace attn_body {
using bf16=__hip_bfloat16;
using bf16x8=__attribute__((ext_vector_type(8)))short;
using s16x4=__attribute__((ext_vector_type(4)))short;
using f32x16=__attribute__((ext_vector_type(16)))float;
using u32x4=__attribute__((ext_vector_type(4)))unsigned;
constexpr int BATCH=8,SEQ=2048,D=64,ZPI=4608,OPI=1024;
constexpr int NW=8,QBLK=32,QB=QBLK*NW,KVBLK=64,NQB=SEQ/QB;
constexpr int ATTN_UNIT_ROWS=QB;
__device__ __forceinline__ int crow(int r,int hi){return (r&3)+8*(r>>2)+4*hi;}
#define SBAR() __builtin_amdgcn_sched_barrier(0)
__device__ __forceinline__ void cmask(f32x16&p0,f32x16&p1,int jb,int qrel,int hi){
  const float NEG=-INFINITY; int kb=64*jb+4*hi;
  #pragma unroll
  for(int r=0;r<16;++r){int kv=kb+(r&3)+8*(r>>2); if(kv>qrel)p0[r]=NEG; if(kv+32>qrel)p1[r]=NEG;}
}

constexpr int NSLOT=3, SLOTB=8192;
constexpr int LDS_K=0, LDS_V=NSLOT*SLOTB, LDS_WS=2*NSLOT*SLOTB, LDS_OST=LDS_WS+NW*64*4, LDS_BYTES=LDS_OST+NW*4096;
constexpr float C2=0.125f*1.4426950408889634f;
__device__ __forceinline__ void glds16(const void*gsrc,unsigned lds_dst){unsigned keep;
  asm volatile("s_mov_b32 %0, m0\n\ts_mov_b32 m0, %2\n\ts_nop 0\n\tglobal_load_lds_dwordx4 %1, off\n\ts_mov_b32 m0, %0":"=&s"(keep):"v"(gsrc),"s"(lds_dst):"memory");}
__device__ __forceinline__ float max3f(float a,float b,float c){float r;asm("v_max3_f32 %0, %1, %2, %3":"=v"(r):"v"(a),"v"(b),"v"(c));return r;}
__device__ __forceinline__ float max2f(float a,float b){float r;asm("v_max_f32_e32 %0, %1, %2":"=v"(r):"v"(a),"v"(b));return r;}
__device__ __forceinline__ float fadd_s(float a,float b){float r;asm("v_add_f32_e32 %0, %1, %2":"=v"(r):"v"(a),"v"(b));return r;}
__device__ __forceinline__ float fsub_s(float a,float b){float r;asm("v_sub_f32_e32 %0, %1, %2":"=v"(r):"v"(a),"v"(b));return r;}
typedef float f32x2_t __attribute__((ext_vector_type(2))); typedef __bf16 bf16x2_t __attribute__((ext_vector_type(2)));
__device__ __forceinline__ unsigned cvtpk_s(float lo,float hi){f32x2_t v={lo,hi};bf16x2_t b=__builtin_convertvector(v,bf16x2_t);return __builtin_bit_cast(unsigned,b);}
#define WAIT_BAR(N) asm volatile("s_waitcnt vmcnt(" #N ") lgkmcnt(0)\n\ts_barrier":::"memory")

__device__ __forceinline__ void qkt(f32x16&p0,f32x16&p1,const char*Kslot,const bf16x8*qr,const f32x16&negm,int r32,int hi){
  const char*kb=Kslot+hi*1024+r32*16;
  #pragma unroll
  for(int d0=0;d0<4;++d0){
    const bf16x8 b0=*reinterpret_cast<const bf16x8*>(kb+d0*2048);
    const bf16x8 b1=*reinterpret_cast<const bf16x8*>(kb+d0*2048+512);
    if(d0==0){p0=__builtin_amdgcn_mfma_f32_32x32x16_bf16(b0,qr[0],negm,0,0,0);p1=__builtin_amdgcn_mfma_f32_32x32x16_bf16(b1,qr[0],negm,0,0,0);}
    else{p0=__builtin_amdgcn_mfma_f32_32x32x16_bf16(b0,qr[d0],p0,0,0,0);p1=__builtin_amdgcn_mfma_f32_32x32x16_bf16(b1,qr[d0],p1,0,0,0);}}
}
typedef __attribute__((address_space(3))) const char* lds_cptr;
typedef short v4i16_t __attribute__((ext_vector_type(4)));
__device__ __forceinline__ void kload8(bf16x8*kf,lds_cptr kp){
  kf[0]=*(const __attribute__((address_space(3))) bf16x8*)(kp);      kf[1]=*(const __attribute__((address_space(3))) bf16x8*)(kp+512);
  kf[2]=*(const __attribute__((address_space(3))) bf16x8*)(kp+2048); kf[3]=*(const __attribute__((address_space(3))) bf16x8*)(kp+2560);
  kf[4]=*(const __attribute__((address_space(3))) bf16x8*)(kp+4096); kf[5]=*(const __attribute__((address_space(3))) bf16x8*)(kp+4608);
  kf[6]=*(const __attribute__((address_space(3))) bf16x8*)(kp+6144); kf[7]=*(const __attribute__((address_space(3))) bf16x8*)(kp+6656);
}
__device__ __forceinline__ void kload2(bf16x8*kf,lds_cptr kp,int j){ kf[2*j]=*(const __attribute__((address_space(3))) bf16x8*)(kp+j*2048); kf[2*j+1]=*(const __attribute__((address_space(3))) bf16x8*)(kp+j*2048+512); }
__device__ __forceinline__ s16x4 vtr(lds_cptr p){ return __builtin_bit_cast(s16x4,__builtin_amdgcn_ds_read_tr16_b64_v4i16((__attribute__((address_space(3))) v4i16_t*)p)); }
__device__ __forceinline__ float rowmax(const f32x16&p0,const f32x16&p1){
  float a=max3f(p0[0],p0[1],p1[0]),b=max3f(p0[2],p0[3],p1[1]);a=max3f(a,p1[2],p1[3]);
  #pragma unroll
  for(int r=4;r<16;r+=4){a=max3f(a,p0[r],p0[r+1]);b=max3f(b,p0[r+2],p0[r+3]);a=max3f(a,p1[r],p1[r+1]);b=max3f(b,p1[r+2],p1[r+3]);}
  const float m=max2f(a,b);
  auto rr=__builtin_amdgcn_permlane32_swap(__float_as_uint(m),__float_as_uint(m),false,false);
  return max2f(__uint_as_float(rr[0]),__uint_as_float(rr[1]));
}
__device__ __forceinline__ void pv(f32x16*o,int vb,bf16x8 pa0,bf16x8 pa1,bf16x8 pa2,bf16x8 pa3){
  #pragma unroll
  for(int d0=0;d0<2;++d0){s16x4 lo[4],hi[4];
    #pragma unroll
    for(int ks=0;ks<4;++ks){
      asm volatile("ds_read_b64_tr_b16 %0,%1 offset:%c2":"=&v"(lo[ks]):"v"(vb),"i"(d0*4096+ks*1024):"memory");
      asm volatile("ds_read_b64_tr_b16 %0,%1 offset:%c2":"=&v"(hi[ks]):"v"(vb),"i"(d0*4096+ks*1024+512):"memory");}
    asm volatile("s_waitcnt lgkmcnt(0)":::"memory");SBAR();
    #define PK(k) (bf16x8){lo[k][0],lo[k][1],lo[k][2],lo[k][3],hi[k][0],hi[k][1],hi[k][2],hi[k][3]}
    o[d0]=__builtin_amdgcn_mfma_f32_32x32x16_bf16(pa0,PK(0),o[d0],0,0,0);
    o[d0]=__builtin_amdgcn_mfma_f32_32x32x16_bf16(pa1,PK(1),o[d0],0,0,0);
    o[d0]=__builtin_amdgcn_mfma_f32_32x32x16_bf16(pa2,PK(2),o[d0],0,0,0);
    o[d0]=__builtin_amdgcn_mfma_f32_32x32x16_bf16(pa3,PK(3),o[d0],0,0,0);
    #undef PK
  }
}

#ifndef ATTN_STORE16
#define ATTN_STORE16(p,v) (*(u32x4*)(p)=(v))
#endif
template<int THRL> __device__ __forceinline__ void attn_unit(int b,int qb,const bf16*Q,const bf16*__restrict__ K,const bf16*__restrict__ V,bf16*O,char*shm){
  int tid=threadIdx.x; asm volatile("":"+v"(tid)); const int lane=tid&63,r32=lane&31,hi=lane>>5; const int wid=__builtin_amdgcn_readfirstlane(tid>>6);
  const long rowbase=(long)b*SEQ; const int q0=qb*QB;
  const bf16*Qw=Q+(rowbase+q0+wid*QBLK)*ZPI;
  const bf16*Kh=K+rowbase*ZPI,*Vh=V+rowbase*ZPI;
  const unsigned lds0=(unsigned)(uintptr_t)shm;
  float*wsf=(float*)(shm+LDS_WS)+wid*64;
  const bf16*ksrc=Kh+(long)lane*ZPI+wid*8;
  const bf16*vsrc=Vh+(long)(16*(wid&3)+(lane>>2))*ZPI+(wid>>2)*32+(lane&3)*8;
  const unsigned kdst=lds0+LDS_K+wid*1024, vdst=lds0+LDS_V+wid*1024;
  #define DMA_K(t,slot) glds16(ksrc+(long)(t)*KVBLK*ZPI,(unsigned)__builtin_amdgcn_readfirstlane(kdst+(slot)))
  #define DMA_V(t,slot) glds16(vsrc+(long)(t)*KVBLK*ZPI,(unsigned)__builtin_amdgcn_readfirstlane(vdst+(slot)))
  const int vb0=(int)(lds0+LDS_V)+((lane>>4)&1)*32+(lane&3)*8+(4*hi+((lane&15)>>2))*64;
  const char*Kbase=shm+LDS_K; bf16x8 kf[8];
  const lds_cptr shm3=(lds_cptr)shm; const lds_cptr kp0=shm3+LDS_K+hi*1024+r32*16; const lds_cptr vp0=shm3+LDS_V+((lane>>4)&1)*32+(lane&3)*8+(4*hi+((lane&15)>>2))*64;
  const int NT=(q0+QB)/KVBLK;
  DMA_K(0,0);DMA_V(0,0);DMA_K(1,SLOTB);
  bf16x8 qr[4];
  #pragma unroll
  for(int d0=0;d0<4;++d0)qr[d0]=*reinterpret_cast<const bf16x8*>(&Qw[(long)r32*ZPI+d0*16+hi*8]);
  float mhat=0.f,l_reg=0.f;f32x16 o[2];o[0]=f32x16{};o[1]=f32x16{};f32x16 negm=f32x16{};asm volatile("":"+v"(negm));
  const int qrel=wid*QBLK+r32;
  #define CMASK(P0,P1,t) do{int jb_=(t)-(NT-4); if(jb_>=0)cmask(P0,P1,jb_,qrel,hi);}while(0)
  bool resc=false;
  #define START(P0,P1) do{ const float rm=rowmax(P0,P1); resc=false; \
    { const float dl=rm; mhat=fadd_s(mhat,dl); \
      _Pragma("unroll") for(int r=0;r<16;++r){P0[r]=fsub_s(P0[r],dl);P1[r]=fsub_s(P1[r],dl);} \
      _Pragma("unroll") for(int r=0;r<16;++r)negm[r]=-mhat; asm volatile("":"+v"(negm)); } \
    _Pragma("unroll") for(int r=0;r<16;++r)P0[r]=__builtin_amdgcn_exp2f(P0[r]); }while(0)
  #define RESC() do{ if(resc){ asm volatile("s_waitcnt lgkmcnt(0)":::"memory"); \
      _Pragma("unroll") for(int d_=0;d_<2;++d_) _Pragma("unroll") for(int r=0;r<16;++r)o[d_][r]*=wsf[crow(r,hi)]; } }while(0)
  f32x16 pA0,pA1,pB0,pB1;
  int sl_prev=0,sl_cur=0,sl_next=SLOTB;
  #define ROT() do{sl_prev=sl_cur;sl_cur=sl_next;sl_next=(sl_next==(NSLOT-1)*SLOTB)?0:sl_next+SLOTB;}while(0)
  DMA_K(2,2*SLOTB);
  WAIT_BAR(3);
  qkt(pA0,pA1,Kbase,qr,negm,r32,hi);asm volatile("s_nop 15\n\ts_nop 7":"+v"(pA0),"+v"(pA1));CMASK(pA0,pA1,0);
  START(pA0,pA1);
  _Pragma("unroll") for(int r=0;r<16;++r)pA1[r]=__builtin_amdgcn_exp2f(pA1[r]);
  WAIT_BAR(0);
  DMA_K(3,0);DMA_V(1,SLOTB);
  ROT();
  kload8(kf,kp0+sl_cur);
  WAIT_BAR(2);
  s16x4 vlo[8],vhi[8]; u32x4 pw0,pw1,pw2,pw3;
  #define PKW(P,B) cvtpk_s(P[B],P[B+1])
  #define PAF(k) __builtin_bit_cast(bf16x8,pw##k)
  #define VFR(i) (bf16x8){vlo[i][0],vlo[i][1],vlo[i][2],vlo[i][3],vhi[i][0],vhi[i][1],vhi[i][2],vhi[i][3]}
  #define PIN(x) asm volatile("":"+v"(x))
  #define MX3(a,b,c) __builtin_fmaxf(__builtin_fmaxf((a),(b)),(c))
  #define GAPA(MF,A0,A1,A2,A3,W0,W1,PW) do{ MF; sacc+=A0; sacc+=A1; sacc+=A2; sacc+=A3; PIN(sacc); W0; W1; PIN(PW); SBAR(); }while(0)
  #define EX(v) __builtin_amdgcn_exp2f(v)
  #define GAPB(MF,X,B) do{ MF; X[B]=EX(X[B]); X[B+1]=EX(X[B+1]); X[B+2]=EX(X[B+2]); X[B+3]=EX(X[B+3]); PIN(X); SBAR(); }while(0)
  #define VRD(i) do{ vlo[i]=vtr(vp_+(((i)>>2)*4096+((i)&3)*1024)); vhi[i]=vtr(vp_+(((i)>>2)*4096+((i)&3)*1024+512)); }while(0)
  #define KRD(G,j) do{ if(G){ kload2(kf,kp0+sl_next,j); SBAR(); } }while(0)
  #define STEP(C0,C1,P0,P1,t,GK,GV,GL) do{ SBAR(); \
    const lds_cptr vp_=vp0+sl_prev; \
    VRD(0); SBAR(); float sacc=(P0[0]+P0[1]); \
    GAPA(C0=__builtin_amdgcn_mfma_f32_32x32x16_bf16(kf[0],qr[0],negm,0,0,0), P0[2],P0[3],P0[4],P0[5],     pw0[0]=PKW(P0,0), pw0[1]=PKW(P0,2), pw0); \
    VRD(4); SBAR(); GAPA(C1=__builtin_amdgcn_mfma_f32_32x32x16_bf16(kf[1],qr[0],negm,0,0,0), P0[6],P0[7],P0[8],P0[9],     pw0[2]=PKW(P0,4), pw0[3]=PKW(P0,6), pw0); \
    VRD(1); SBAR(); GAPA(C0=__builtin_amdgcn_mfma_f32_32x32x16_bf16(kf[2],qr[1],C0,0,0,0),   P0[10],P0[11],P0[12],P0[13], pw1[0]=PKW(P0,8), pw1[1]=PKW(P0,10), pw1); \
    VRD(5); SBAR(); GAPA(C1=__builtin_amdgcn_mfma_f32_32x32x16_bf16(kf[3],qr[1],C1,0,0,0),   P0[14],P0[15],P1[0],P1[1],   pw1[2]=PKW(P0,12),pw1[3]=PKW(P0,14), pw1); \
    VRD(2); SBAR(); GAPA(C0=__builtin_amdgcn_mfma_f32_32x32x16_bf16(kf[4],qr[2],C0,0,0,0),   P1[2],P1[3],P1[4],P1[5],     pw2[0]=PKW(P1,0), pw2[1]=PKW(P1,2), pw2); \
    VRD(6); SBAR(); GAPA(C1=__builtin_amdgcn_mfma_f32_32x32x16_bf16(kf[5],qr[2],C1,0,0,0),   P1[6],P1[7],P1[8],P1[9],     pw2[2]=PKW(P1,4), pw2[3]=PKW(P1,6), pw2); \
    VRD(3); SBAR(); GAPA(C0=__builtin_amdgcn_mfma_f32_32x32x16_bf16(kf[6],qr[3],C0,0,0,0),   P1[10],P1[11],P1[12],P1[13], pw3[0]=PKW(P1,8), pw3[1]=PKW(P1,10), pw3); \
    VRD(7); SBAR(); GAPA(C1=__builtin_amdgcn_mfma_f32_32x32x16_bf16(kf[7],qr[3],C1,0,0,0),   P1[14],P1[15],0.f,0.f,       pw3[2]=PKW(P1,12),pw3[3]=PKW(P1,14), pw3); \
    l_reg+=sacc; \
    if(GK){DMA_K((t)+3,sl_cur);} if(GV){DMA_V((t)+1,sl_next);} \
    CMASK(C0,C1,t); \
    { float a=MX3(C0[0],C0[1],C1[0]),b=MX3(C0[2],C0[3],C1[1]); a=MX3(a,C1[2],C1[3]); \
      _Pragma("unroll") for(int r=4;r<16;r+=4){a=MX3(a,C0[r],C0[r+1]);b=MX3(b,C0[r+2],C0[r+3]);a=MX3(a,C1[r],C1[r+1]);b=MX3(b,C1[r+2],C1[r+3]);} \
      float rm=__builtin_fmaxf(a,b); { auto rr=__builtin_amdgcn_permlane32_swap(__float_as_uint(rm),__float_as_uint(rm),false,false); rm=__builtin_fmaxf(__uint_as_float(rr[0]),__uint_as_float(rr[1])); } \
      resc=false; \
      if(__builtin_expect(__any(rm>(float)THRL),0)){ const float dl=__builtin_fmaxf(rm,0.f); mhat+=dl; \
        _Pragma("unroll") for(int r=0;r<16;++r){C0[r]-=dl;C1[r]-=dl;} \
        _Pragma("unroll") for(int r=0;r<16;++r)negm[r]=-mhat; asm volatile("":"+v"(negm)); \
        const float f=__builtin_amdgcn_exp2f(-dl); l_reg*=f; if(hi==0)wsf[r32]=f; resc=true; } } \
    SBAR(); \
    GAPB(o[0]=__builtin_amdgcn_mfma_f32_32x32x16_bf16(PAF(0),VFR(0),o[0],0,0,0), C0,0); \
    GAPB(o[1]=__builtin_amdgcn_mfma_f32_32x32x16_bf16(PAF(0),VFR(4),o[1],0,0,0), C0,4); \
    KRD(GL,0); GAPB(o[0]=__builtin_amdgcn_mfma_f32_32x32x16_bf16(PAF(1),VFR(1),o[0],0,0,0), C0,8); \
    KRD(GL,1); GAPB(o[1]=__builtin_amdgcn_mfma_f32_32x32x16_bf16(PAF(1),VFR(5),o[1],0,0,0), C0,12); \
    KRD(GL,2); GAPB(o[0]=__builtin_amdgcn_mfma_f32_32x32x16_bf16(PAF(2),VFR(2),o[0],0,0,0), C1,0); \
    KRD(GL,3); GAPB(o[1]=__builtin_amdgcn_mfma_f32_32x32x16_bf16(PAF(2),VFR(6),o[1],0,0,0), C1,4); \
    GAPB(o[0]=__builtin_amdgcn_mfma_f32_32x32x16_bf16(PAF(3),VFR(3),o[0],0,0,0), C1,8); \
    GAPB(o[1]=__builtin_amdgcn_mfma_f32_32x32x16_bf16(PAF(3),VFR(7),o[1],0,0,0), C1,12); \
    }while(0)
  int t=1;
  #undef CMASK
  #define CMASK(P0,P1,t) do{}while(0)
  for(;t+5<NT;t+=2){
    STEP(pB0,pB1,pA0,pA1,t,true,true,true);     WAIT_BAR(2); RESC(); ROT();
    STEP(pA0,pA1,pB0,pB1,t+1,true,true,true);   WAIT_BAR(2); RESC(); ROT();
  }
  #undef CMASK
  #define CMASK(P0,P1,t) do{int jb_=(t)-(NT-4); if(jb_>=0)cmask(P0,P1,jb_,qrel,hi);}while(0)
  #define ENDW(tt) do{ if((tt)+3<NT){WAIT_BAR(2);} else if((tt)+2<NT){WAIT_BAR(1);} else {WAIT_BAR(0);} }while(0)
  for(;t+1<NT;t+=2){
    STEP(pB0,pB1,pA0,pA1,t,(t+3<NT),(t+1<NT),(t+1<NT));       ENDW(t);   RESC(); ROT();
    STEP(pA0,pA1,pB0,pB1,t+1,(t+4<NT),(t+2<NT),(t+2<NT));     ENDW(t+1); RESC(); ROT();
  }
  STEP(pB0,pB1,pA0,pA1,NT-1,false,false,false); RESC();
  { float sacc=pB0[0]+pB0[1]; _Pragma("unroll") for(int r=2;r<16;++r)sacc+=pB0[r]; _Pragma("unroll") for(int r=0;r<16;++r)sacc+=pB1[r]; l_reg+=sacc;
    pw0=(u32x4){PKW(pB0,0),PKW(pB0,2),PKW(pB0,4),PKW(pB0,6)};pw1=(u32x4){PKW(pB0,8),PKW(pB0,10),PKW(pB0,12),PKW(pB0,14)};pw2=(u32x4){PKW(pB1,0),PKW(pB1,2),PKW(pB1,4),PKW(pB1,6)};pw3=(u32x4){PKW(pB1,8),PKW(pB1,10),PKW(pB1,12),PKW(pB1,14)};
    SBAR(); pv(o,vb0+sl_cur,PAF(0),PAF(1),PAF(2),PAF(3)); }
  #undef PKW
  #undef PAF
  #undef VFR
  #undef PIN
  #undef MX3
  #undef GAPA
  #undef GAPB
  #undef EX
  #undef VRD
  #undef KRD
  #undef STEP
  #undef ENDW
  {auto rr=__builtin_amdgcn_permlane32_swap(__float_as_uint(l_reg),__float_as_uint(l_reg),false,false);l_reg=__uint_as_float(rr[0])+__uint_as_float(rr[1]);}
  if(hi==0)wsf[32+r32]=l_reg;asm volatile("s_waitcnt lgkmcnt(0)":::"memory");
  float rli[16];
  #pragma unroll
  for(int r=0;r<16;++r)rli[r]=__builtin_amdgcn_rcpf(wsf[32+crow(r,hi)]);
  bf16*Ow=O+(rowbase+q0+wid*QBLK)*OPI;
  { bf16*stg=(bf16*)(shm+LDS_OST)+wid*2048;
    #pragma unroll
    for(int r=0;r<16;++r){const int orow=crow(r,hi);
      #pragma unroll
      for(int d0=0;d0<2;++d0)stg[orow*64+d0*32+r32]=__float2bfloat16(o[d0][r]*rli[r]);}
    asm volatile("s_waitcnt lgkmcnt(0)":::"memory");
    #pragma unroll
    for(int i=0;i<4;++i){const int row=i*8+(lane>>3),ch=lane&7; const u32x4 v=*(const u32x4*)(stg+row*64+ch*8); ATTN_STORE16(Ow+(long)row*OPI+ch*8,v);} }
  asm volatile("s_waitcnt lgkmcnt(0)\n\ts_barrier":::"memory");
  #undef DMA_K
  #undef DMA_V
  #undef CMASK
  #undef START
  #undef RESC
  #undef ROT
}
constexpr int ATTN_LDS_BYTES=LDS_BYTES;
#undef SBAR
#undef WAIT_BAR
}

namespace cg = cooperative_groups;
#ifndef PROBE_SEL
#define PROBE_SEL 0
#endif
#define LAS __attribute__((address_space(3)))
typedef unsigned short bf16;
typedef unsigned v4u __attribute__((ext_vector_type(4)));
typedef unsigned v2u __attribute__((ext_vector_type(2)));
typedef float f32x4 __attribute__((ext_vector_type(4)));
typedef short bf16x8 __attribute__((ext_vector_type(8)));

constexpr int NWAVES = 8;
constexpr int M = 16384, DM = 1024, SEQ = 2048, NBATCH = 8, ZP = 4608, UP = 5632, DFF = 2816, DIN = 4616, DMIX = 1536;
constexpr int DEPTH = 2;
constexpr float EPS = 1e-6f;
constexpr size_t MiB = 1u << 20;
constexpr size_t WS_CTL = 0;
constexpr size_t WS_RSTD = 64 * 1024;
constexpr size_t WS_RGSS = 128 * 1024;
constexpr size_t WS_GATES = 1 * MiB;
constexpr size_t WS_ROPE = 2 * MiB;
constexpr size_t WS_HALO = 3 * MiB;
constexpr size_t WS_WIN = 9 * MiB;
constexpr size_t WS_WOUT = 18 * MiB + 512 * 1024;
constexpr size_t WS_WUP = 21 * MiB + 512 * 1024;
constexpr size_t WS_WDN = 32 * MiB + 512 * 1024;
constexpr size_t WS_SSA = 192 * 1024;
constexpr size_t WS_XB = 38 * MiB;
constexpr size_t WS_BIG = 70 * MiB;
constexpr size_t WS_UHEAD = 246 * MiB;
constexpr size_t WS_ZHALO = 252 * MiB;
constexpr size_t WS_MLW = WS_BIG + 144 * MiB;
constexpr size_t WS_MLS = WS_BIG + 152 * MiB;
constexpr size_t WS_RGA = WS_BIG + 153 * MiB;
constexpr size_t WS_RGSUM = WS_BIG + 169 * MiB;
constexpr size_t WS_RGHIN = WS_BIG + 170 * MiB;
constexpr size_t WS_MCH = WS_RGHIN + 768 * 1024;
constexpr size_t WS_END = 256 * MiB;
constexpr int LDS_BYTES = 147456, MISC_OFF = 147200;

struct Params {
    const float* x; const int* pos; const float* attn_norm; const float* w_in; const float* rg_conv_w; const float* rg_conv_b; const float* rg_wa; const float* rg_ba;
    const float* rg_wx; const float* rg_bx; const float* rg_lambda; const float* rg_norm; const float* da_lambda; const float* da_norm; const float* ml_conv_w; const float* ml_conv_b;
    const float* ml_i_bias; const float* ml_f_bias; const float* ml_norm; const float* w_out; const float* mlp_norm; const float* w_up; const float* ffn_conv_w; const float* ffn_conv_b;
    const float* w_down; const float* final_norm; float* out; unsigned char* ws;
};

__device__ __forceinline__ unsigned f2bf(float f) { unsigned u = __builtin_bit_cast(unsigned, f); return (u + 0x7fffu + ((u >> 16) & 1u)) >> 16; }
typedef float f32x2_t_ __attribute__((ext_vector_type(2))); typedef __bf16 bf16x2_t_ __attribute__((ext_vector_type(2)));
__device__ __forceinline__ unsigned pk2(float lo, float hi) { f32x2_t_ v = {lo, hi}; bf16x2_t_ b = __builtin_convertvector(v, bf16x2_t_); return __builtin_bit_cast(unsigned, b); }
__device__ __forceinline__ float bflo(unsigned w) { return __uint_as_float(w << 16); }
__device__ __forceinline__ float bfhi(unsigned w) { return __uint_as_float(w & 0xffff0000u); }
__device__ __forceinline__ float wave_sum(float v) {
#pragma unroll
    for (int o = 1; o < 64; o <<= 1) v += __shfl_xor(v, o);
    return v;
}
__device__ __forceinline__ float sigmoidf_(float x) { return __builtin_amdgcn_rcpf(1.f + __expf(-x)); }
__device__ __forceinline__ float logsigmoidf_(float x) { return fminf(x, 0.f) - log1pf(__expf(-fabsf(x))); }
__device__ __forceinline__ float gelu_tanh(float x) { const float y = 0.7978845608028654f * (x + 0.044715f * x * x * x); const float t = 1.f - 2.f * __builtin_amdgcn_rcpf(1.f + __expf(2.f * y)); return 0.5f * x * (1.f + t); }
__device__ __forceinline__ void lds_addf(LAS float* p, float v) { __hip_atomic_fetch_add(p, v, __ATOMIC_RELAXED, __HIP_MEMORY_SCOPE_WORKGROUP); }
template <int CTRL, int RM> __device__ __forceinline__ float dpp_old(float old, float v) { return __int_as_float(__builtin_amdgcn_update_dpp(__float_as_int(old), __float_as_int(v), CTRL, RM, 0xf, false)); }
__device__ __forceinline__ float wave_incl_sum(float v) {
    v += dpp_old<0x111, 0xf>(0.f, v); v += dpp_old<0x112, 0xf>(0.f, v); v += dpp_old<0x114, 0xf>(0.f, v); v += dpp_old<0x118, 0xf>(0.f, v);
    v += dpp_old<0x142, 0xa>(0.f, v); v += dpp_old<0x143, 0xc>(0.f, v); return v; }
__device__ __forceinline__ float wave_incl_max(float v) {
    const float ninf = -__builtin_inff();
    v = fmaxf(v, dpp_old<0x111, 0xf>(ninf, v)); v = fmaxf(v, dpp_old<0x112, 0xf>(ninf, v)); v = fmaxf(v, dpp_old<0x114, 0xf>(ninf, v)); v = fmaxf(v, dpp_old<0x118, 0xf>(ninf, v));
    v = fmaxf(v, dpp_old<0x142, 0xa>(ninf, v)); v = fmaxf(v, dpp_old<0x143, 0xc>(ninf, v)); return v; }
#define MFMA16(a, b, c) __builtin_amdgcn_mfma_f32_16x16x32_bf16((a), (b), (c), 0, 0, 0)
#define LDS_BARRIER() asm volatile("s_waitcnt lgkmcnt(0)\n\ts_barrier" ::: "memory")
#define XB_TMO      128
#define XB_XCNT(j)  (256  + 64 * (j))
#define XB_XSUB(j)  (1280 + 64 * (j))
#define XB_XGEN(j)  (2304 + 64 * (j))
#define XB_TOP      3328
#define XB_TOPGEN   3392
#define XCD_BAR_WORDS 3456
#define XB_SPIN_CAP (1u << 18)

__device__ __forceinline__ unsigned xb_ld(unsigned* p)              { return __hip_atomic_load(p, __ATOMIC_RELAXED, __HIP_MEMORY_SCOPE_AGENT); }
__device__ __forceinline__ unsigned xb_add(unsigned* p, unsigned v) { return __hip_atomic_fetch_add(p, v, __ATOMIC_RELAXED, __HIP_MEMORY_SCOPE_AGENT); }
__device__ __forceinline__ unsigned xb_xcc_id() { return (unsigned)__builtin_amdgcn_s_getreg((3 << 11) | 20) & 0xFu; }
#define XB_SPIN(cond, bar) do { unsigned _sp = 0; while (cond) { __builtin_amdgcn_s_sleep(1); \
    if ((++_sp & 255u) == 0u) { if (xb_ld(&(bar)[XB_TMO])) break; if (_sp > XB_SPIN_CAP) { atomicAdd(&(bar)[XB_TMO], 1u); break; } } } } while (0)

struct XcdBarrier {
    unsigned* bar; unsigned x;
    volatile LAS unsigned* st;
};

__device__ __forceinline__ XcdBarrier xcd_barrier_post(unsigned* bar, volatile LAS unsigned* st) {
    XcdBarrier b; b.bar = bar; b.x = xb_xcc_id(); b.st = st;
    if (threadIdx.x == 0) (void)xb_add(&bar[XB_XCNT(b.x)], 1u);
    return b;
}
__device__ __forceinline__ void xcd_barrier_complete(unsigned* bar, unsigned x, unsigned& nloc, unsigned& nx) {
    const unsigned G = gridDim.x * gridDim.y * gridDim.z;
    unsigned sum, cnt, mine, sp = 0u;
    for (;;) {
        sum = 0u; cnt = 0u; mine = 0u;
#pragma unroll
        for (unsigned j = 0; j < 16; ++j) { const unsigned c = xb_ld(&bar[XB_XCNT(j)]); sum += c; cnt += (c > 0u) ? 1u : 0u; mine = (j == x) ? c : mine; }
        if (sum == G) break;
        __builtin_amdgcn_s_sleep(1);
        if ((++sp & 255u) == 0u) { if (xb_ld(&bar[XB_TMO])) break; if (sp > XB_SPIN_CAP) { atomicAdd(&bar[XB_TMO], 1u); break; } }
    }
    nloc = mine > 0u ? mine : 1u; nx = cnt > 0u ? cnt : 1u;
}

__device__ __forceinline__ void xcd_barrier(const XcdBarrier& b) {
    asm volatile("s_waitcnt vmcnt(0)" ::: "memory");
    __syncthreads();
    if (threadIdx.x == 0) {
        unsigned* bar = b.bar;
        __builtin_amdgcn_s_waitcnt(0);
        unsigned nloc = b.st[0], nx = b.st[1];
        if (nloc == 0u) { xcd_barrier_complete(bar, b.x, nloc, nx); b.st[0] = nloc; b.st[1] = nx; }
        const unsigned old = xb_add(&bar[XB_XSUB(b.x)], 1u);
        const unsigned gen = old / nloc;
        if (old + 1u == (gen + 1u) * nloc) {
            __builtin_amdgcn_fence(__ATOMIC_RELEASE, "agent");
            asm volatile("s_waitcnt vmcnt(0)" ::: "memory");
            const unsigned og = xb_add(&bar[XB_TOP], 1u);
            const unsigned tg = og / nx;
            if (og + 1u == (tg + 1u) * nx) xb_add(&bar[XB_TOPGEN], 1u);
            else XB_SPIN(xb_ld(&bar[XB_TOPGEN]) == tg, bar);
            __builtin_amdgcn_fence(__ATOMIC_ACQUIRE, "agent");
            xb_add(&bar[XB_XGEN(b.x)], 1u);
            asm volatile("s_waitcnt vmcnt(0)" ::: "memory");
        } else {
            XB_SPIN(xb_ld(&bar[XB_XGEN(b.x)]) == gen, bar);
            __builtin_amdgcn_fence(__ATOMIC_ACQUIRE, "agent");
            asm volatile("s_waitcnt vmcnt(0)" ::: "memory");
        }
    }
    __syncthreads();
}


__device__ __forceinline__ void transpose_item(const float* W, int ldw, int srccol, const float* gain, bf16* WT, int K, int dstrow, LAS float* scr, int k0, int lane, int nvalid = 32) {
    float tv[32];
#pragma unroll
    for (int i = 0; i < 32; ++i) { const int kk = 2 * i + (lane >> 5); tv[i] = ((lane & 31) < nvalid) ? W[(size_t)(k0 + kk) * ldw + srccol + (lane & 31)] : 0.f; }
    if (gain) {
#pragma unroll
        for (int i = 0; i < 32; ++i) tv[i] *= gain[k0 + 2 * i + (lane >> 5)]; }
#pragma unroll
    for (int i = 0; i < 32; ++i) scr[(2 * i + (lane >> 5)) * 33 + (lane & 31)] = tv[i];
    asm volatile("s_waitcnt lgkmcnt(0)" ::: "memory");
    const int c = lane & 7;
#pragma unroll
    for (int j = 0; j < 4; ++j) { const int n = (lane >> 3) + 8 * j; const LAS float* s = scr + (8 * c) * 33 + n;
        v4u o; o.x = pk2(s[0 * 33], s[1 * 33]); o.y = pk2(s[2 * 33], s[3 * 33]); o.z = pk2(s[4 * 33], s[5 * 33]); o.w = pk2(s[6 * 33], s[7 * 33]);
        *(v4u*)(WT + (size_t)(dstrow + n) * K + k0 + 8 * c) = o; }
    asm volatile("s_waitcnt lgkmcnt(0)" ::: "memory");
}
__device__ __forceinline__ int zcol_to_orig(int n0) {
    const int blk = n0 >> 9, r = n0 & 511;
    const int o = blk == 0 ? 0 : blk == 1 ? 512 : blk == 2 ? 1024 : blk == 3 ? 4096 : blk == 4 ? 1536 : blk == 5 ? 2048 : blk == 6 ? 2560 : blk == 7 ? 3072 : 3584;
    return o + r;
}
template <int PART> __device__ __forceinline__ void convert_weights(const Params& P, int l, LAS unsigned char* lds, int gw, int NGW, int wave, int lane) {
    LAS float* scr = (LAS float*)(lds + wave * 16384);
    constexpr int I_IN = 16 * 152, I_OUT = 24 * 32, I_UP = 16 * 176, I_DN = 44 * 32, NITEMS = I_IN + I_OUT + I_UP + I_DN;
    unsigned char* ws = P.ws;
    for (int it = (PART == 0 ? 0 : I_IN) + gw; it < (PART == 0 ? I_IN : NITEMS); it += NGW) {
        int r = it;
        if (r < I_IN) { const int kb = r / 152, nb = r % 152; transpose_item(P.w_in + (size_t)l * DM * DIN, DIN, nb < 144 ? zcol_to_orig(32 * nb) : 4608, P.attn_norm + l * DM, (bf16*)(ws + WS_WIN), DM, 32 * nb, scr, 64 * kb, lane, nb < 144 ? 32 : (nb == 144 ? 8 : 0)); continue; } r -= I_IN;
        if (r < I_OUT) { const int kb = r / 32, nb = r % 32; transpose_item(P.w_out + (size_t)l * DMIX * DM, DM, 32 * nb, nullptr, (bf16*)(ws + WS_WOUT), DMIX, 32 * nb, scr, 64 * kb, lane); continue; } r -= I_OUT;
        if (r < I_UP) { const int kb = r / 176, nb = r % 176; transpose_item(P.w_up + (size_t)l * DM * UP, UP, ((32 * nb) & 255) < 128 ? ((32 * nb) >> 8) * 128 + ((32 * nb) & 255) : DFF + ((32 * nb) >> 8) * 128 + ((32 * nb) & 255) - 128, P.mlp_norm + l * DM, (bf16*)(ws + WS_WUP), DM, 32 * nb, scr, 64 * kb, lane); continue; } r -= I_UP;
        { const int kb = r / 32, nb = r % 32; transpose_item(P.w_down + (size_t)l * DFF * DM, DM, 32 * nb, nullptr, (bf16*)(ws + WS_WDN), DFF, 32 * nb, scr, 64 * kb, lane); }
    }
}
template <bool GATES> __device__ __forceinline__ void rowpass(const float* x, bf16* xb, float* rstd, const LAS float* wgT, float* gates, int gw, int NGW, int lane) {
    for (int m = gw; m < M; m += 2 * NGW) {
        const int m2 = m + NGW; const bool has2 = m2 < M;
        const f32x4* xr = (const f32x4*)(x + (size_t)m * DM) + lane; const f32x4* xr2 = (const f32x4*)(x + (size_t)(has2 ? m2 : m) * DM) + lane;
        f32x4 v[4], w[4]; float s = 0.f, s2 = 0.f;
#pragma unroll
        for (int j = 0; j < 4; ++j) { v[j] = xr[64 * j]; w[j] = xr2[64 * j]; }
#pragma unroll
        for (int j = 0; j < 4; ++j) { s += (v[j].x * v[j].x + v[j].y * v[j].y) + (v[j].z * v[j].z + v[j].w * v[j].w); s2 += (w[j].x * w[j].x + w[j].y * w[j].y) + (w[j].z * w[j].z + w[j].w * w[j].w); }
        s = wave_sum(s); s2 = wave_sum(s2);
        if (lane == 0) { rstd[m] = s; if (has2) rstd[m2] = s2; }
        unsigned long long* o8 = (unsigned long long*)(xb + (size_t)m * DM) + lane;
#pragma unroll
        for (int j = 0; j < 4; ++j) o8[64 * j] = (unsigned long long)pk2(v[j].x, v[j].y) | ((unsigned long long)pk2(v[j].z, v[j].w) << 32);
        if (has2) { unsigned long long* p8 = (unsigned long long*)(xb + (size_t)m2 * DM) + lane;
#pragma unroll
            for (int j = 0; j < 4; ++j) p8[64 * j] = (unsigned long long)pk2(w[j].x, w[j].y) | ((unsigned long long)pk2(w[j].z, w[j].w) << 32); }
    }
}
__device__ __forceinline__ void finalize_mixers(const Params& P, int l, int gw, int NGW, int lane) {
    bf16* z = (bf16*)(P.ws + WS_BIG); const bf16* op = (const bf16*)(P.ws + WS_XB); const bf16* rga = (const bf16*)(P.ws + WS_RGA); const float* hin = (const float*)(P.ws + WS_RGHIN);
    const float lambda_init = 0.8f - 0.6f * expf(-0.3f * (float)l);
    const float* lp = P.da_lambda + l * 256;
    const float lam = expf(wave_sum(lp[lane] * lp[64 + lane])) - expf(wave_sum(lp[128 + lane] * lp[192 + lane])) + lambda_init;
    const float* gr = P.rg_norm + l * 512 + 8 * lane; const float* gd = P.da_norm + l * 128 + (lane & 15) * 8;
    float grg[8], gda[8];
#pragma unroll
    for (int i = 0; i < 8; ++i) { grg[i] = gr[i]; gda[i] = gd[i] * (1.f - lambda_init); }
    const int hh = lane >> 4, colw = (lane & 15) * 8, e = colw >> 6, d = colw & 63;
    v4u c_hw, c_aw, c_gw, c_a, c_b, n_hw, n_aw, n_gw, n_a, n_b; f32x4 c_h0, c_h1, n_h0, n_h1;
#define FM_LOAD(MM, HW, AW, GW, H0, H1, A_, B_) do { const bf16* zr_ = z + (size_t)(MM) * ZP; const int bb_ = (MM) >> 11, cc_ = ((MM) & 2047) >> 6; \
        HW = *(const v4u*)(zr_ + 8 * lane); AW = *(const v4u*)(rga + (size_t)(MM) * 512 + 8 * lane); GW = *(const v4u*)(zr_ + 512 + 8 * lane); \
        { const float* hp_ = hin + (size_t)(bb_ * 32 + cc_) * 512 + 8 * lane; H0 = *(const f32x4*)hp_; H1 = *(const f32x4*)(hp_ + 4); } \
        A_ = *(const v4u*)(op + (size_t)(MM) * DM + ((hh * 2 + 0) * 2 + e) * 64 + d); B_ = *(const v4u*)(op + (size_t)(MM) * DM + ((hh * 2 + 1) * 2 + e) * 64 + d); } while (0)
    if (gw < M) FM_LOAD(gw, c_hw, c_aw, c_gw, c_h0, c_h1, c_a, c_b);
    for (int m = gw; m < M; m += NGW) {
        bf16* zr = z + (size_t)m * ZP;
        const int mn = m + NGW;
        if (mn < M) FM_LOAD(mn, n_hw, n_aw, n_gw, n_h0, n_h1, n_a, n_b);
        { const v4u hw = c_hw, aw = c_aw, gw_ = c_gw; const f32x4 h0 = c_h0, h1 = c_h1;
          const float hl[8] = {bflo(hw.x), bfhi(hw.x), bflo(hw.y), bfhi(hw.y), bflo(hw.z), bfhi(hw.z), bflo(hw.w), bfhi(hw.w)};
          const float ap[8] = {bflo(aw.x), bfhi(aw.x), bflo(aw.y), bfhi(aw.y), bflo(aw.z), bfhi(aw.z), bflo(aw.w), bfhi(aw.w)};
          const float gt[8] = {bflo(gw_.x), bfhi(gw_.x), bflo(gw_.y), bfhi(gw_.y), bflo(gw_.z), bfhi(gw_.z), bflo(gw_.w), bfhi(gw_.w)};
          const float hi8[8] = {h0.x, h0.y, h0.z, h0.w, h1.x, h1.y, h1.z, h1.w};
          float y[8], ssum = 0.f;
#pragma unroll
          for (int i = 0; i < 8; ++i) { y[i] = gelu_tanh(gt[i]) * (hl[i] + ap[i] * hi8[i]); ssum += y[i] * y[i]; }
          ssum = wave_sum(ssum);
          const float rn = 1.f / sqrtf(ssum * (1.f / 512.f) + EPS); v4u o;
          o.x = pk2(y[0] * rn * grg[0], y[1] * rn * grg[1]); o.y = pk2(y[2] * rn * grg[2], y[3] * rn * grg[3]);
          o.z = pk2(y[4] * rn * grg[4], y[5] * rn * grg[5]); o.w = pk2(y[6] * rn * grg[6], y[7] * rn * grg[7]);
          *(v4u*)(zr + 512 + 8 * lane) = o; }
        { const v4u a = c_a, b = c_b; float o[8];
          o[0] = bflo(a.x) - lam * bflo(b.x); o[1] = bfhi(a.x) - lam * bfhi(b.x); o[2] = bflo(a.y) - lam * bflo(b.y); o[3] = bfhi(a.y) - lam * bfhi(b.y);
          o[4] = bflo(a.z) - lam * bflo(b.z); o[5] = bfhi(a.z) - lam * bfhi(b.z); o[6] = bflo(a.w) - lam * bflo(b.w); o[7] = bfhi(a.w) - lam * bfhi(b.w);
          float s_ = 0.f;
#pragma unroll
          for (int i = 0; i < 8; ++i) s_ += o[i] * o[i];
          s_ += __shfl_xor(s_, 1); s_ += __shfl_xor(s_, 2); s_ += __shfl_xor(s_, 4); s_ += __shfl_xor(s_, 8);
          const float rn = 1.f / sqrtf(s_ * (1.f / 128.f) + EPS); v4u w;
          w.x = pk2(o[0] * rn * gda[0], o[1] * rn * gda[1]); w.y = pk2(o[2] * rn * gda[2], o[3] * rn * gda[3]); w.z = pk2(o[4] * rn * gda[4], o[5] * rn * gda[5]); w.w = pk2(o[6] * rn * gda[6], o[7] * rn * gda[7]);
          *(v4u*)(zr + 1024 + hh * 128 + colw) = w; }
        c_hw = n_hw; c_aw = n_aw; c_gw = n_gw; c_h0 = n_h0; c_h1 = n_h1; c_a = n_a; c_b = n_b;
    }
#undef FM_LOAD
}
__device__ __forceinline__ void conv_gate(const Params& P, int l, int tid, int rc0, int rc1, int rcs) {
    asm volatile("" : "+v"(tid));
    bf16* H = (bf16*)(P.ws + WS_BIG); const bf16* halo = (const bf16*)(P.ws + WS_HALO); const bf16* uhead = (const bf16*)(P.ws + WS_UHEAD);
    const float* cw = P.ffn_conv_w + (size_t)l * 3 * UP; const float* cb = P.ffn_conv_b + (size_t)l * UP;
    for (int rc = rc0; rc < rc1; rc += rcs) {
        for (int p = tid; p < DFF / 2; p += NWAVES * 64) {
            const int c = 2 * p;
            float g[4][2], v[4][2];
#pragma unroll
            for (int q = 0; q < 2; ++q) { g[0][q] = 0.f; g[1][q] = 0.f; v[0][q] = 0.f; v[1][q] = 0.f; }
            if ((rc & 31) != 0) { const bf16* hp = halo + (size_t)(rc - 1) * 2 * UP;
                const unsigned a = *(const unsigned*)(hp + c), b = *(const unsigned*)(hp + UP + c), cc = *(const unsigned*)(hp + DFF + c), dd = *(const unsigned*)(hp + UP + DFF + c);
                g[0][0] = bflo(a); g[0][1] = bfhi(a); g[1][0] = bflo(b); g[1][1] = bfhi(b); v[0][0] = bflo(cc); v[0][1] = bfhi(cc); v[1][0] = bflo(dd); v[1][1] = bfhi(dd); }
            { const bf16* hp = uhead + (size_t)rc * 2 * UP;
                const unsigned a = *(const unsigned*)(hp + c), b = *(const unsigned*)(hp + UP + c), cc = *(const unsigned*)(hp + DFF + c), dd = *(const unsigned*)(hp + UP + DFF + c);
                g[2][0] = bflo(a); g[2][1] = bfhi(a); g[3][0] = bflo(b); g[3][1] = bfhi(b); v[2][0] = bflo(cc); v[2][1] = bfhi(cc); v[3][0] = bflo(dd); v[3][1] = bfhi(dd); }
#pragma unroll
            for (int t = 0; t < 2; ++t) { float hid[2];
#pragma unroll
                for (int q = 0; q < 2; ++q) { const float ug = cw[c + q] * g[t][q] + cw[UP + c + q] * g[t + 1][q] + cw[2 * UP + c + q] * g[t + 2][q] + cb[c + q];
                    const float uv = cw[DFF + c + q] * v[t][q] + cw[UP + DFF + c + q] * v[t + 1][q] + cw[2 * UP + DFF + c + q] * v[t + 2][q] + cb[DFF + c + q];
                    hid[q] = ug * sigmoidf_(ug) * uv; }
                *(unsigned*)(H + ((size_t)rc * 64 + t) * DFF + c) = pk2(hid[0], hid[1]); }
        }
    }
}
__device__ __forceinline__ void final_norm(const Params& P, int gw, int NGW, int lane, float* dst) {
    f32x4 g[4];
#pragma unroll
    for (int j = 0; j < 4; ++j) g[j] = ((const f32x4*)P.final_norm)[64 * j + lane];
    for (int m = gw; m < M; m += 2 * NGW) {
        const int m2 = m + NGW; const bool has2 = m2 < M;
        const f32x4* xr = (const f32x4*)(P.out + (size_t)m * DM) + lane; const f32x4* xr2 = (const f32x4*)(P.out + (size_t)(has2 ? m2 : m) * DM) + lane;
        f32x4 v[4], w[4]; float s = 0.f, s2 = 0.f;
#pragma unroll
        for (int j = 0; j < 4; ++j) { v[j] = xr[64 * j]; w[j] = xr2[64 * j]; }
#pragma unroll
        for (int j = 0; j < 4; ++j) { s += (v[j].x * v[j].x + v[j].y * v[j].y) + (v[j].z * v[j].z + v[j].w * v[j].w); s2 += (w[j].x * w[j].x + w[j].y * w[j].y) + (w[j].z * w[j].z + w[j].w * w[j].w); }
        s = wave_sum(s); s2 = wave_sum(s2);
        const float r = 1.f / sqrtf(s * (1.f / DM) + EPS), r2 = 1.f / sqrtf(s2 * (1.f / DM) + EPS);
        f32x4* dr = (f32x4*)(dst + (size_t)m * DM) + lane;
#pragma unroll
        for (int j = 0; j < 4; ++j) dr[64 * j] = v[j] * r * g[j];
        if (has2) { f32x4* dr2 = (f32x4*)(dst + (size_t)m2 * DM) + lane;
#pragma unroll
            for (int j = 0; j < 4; ++j) dr2[64 * j] = w[j] * r2 * g[j]; }
    }
}

__device__ __forceinline__ void ml_chain(const Params& P, int l, int b, int h, LAS unsigned char* lds, int tid) {
    asm volatile("" : "+v"(tid));
    const int lane = tid & 63, wid = __builtin_amdgcn_readfirstlane(tid >> 6);
    LAS float* chs = (LAS float*)lds; const float* gates = (const float*)(P.ws + WS_GATES); float* mch = (float*)(P.ws + WS_MCH);
    const float ib = P.ml_i_bias[l * 4 + h], fb = P.ml_f_bias[l * 4 + h];
    for (int j = wid; j < 32; j += 8) { const size_t row = (size_t)b * SEQ + j * 64 + lane;
        const float li = gates[row * 8 + h] + ib, lf = logsigmoidf_(gates[row * 8 + 4 + h] + fb);
        const float bc = wave_incl_sum(lf); const float am = wave_incl_max(li - bc);
        if (lane == 63) { chs[2 * j] = bc; chs[2 * j + 1] = am; } }
    __syncthreads();
    if (tid == 0) { float m = 0.f; for (int j = 0; j < 32; ++j) { __hip_atomic_store(mch + (b * 4 + h) * 32 + j, m, __ATOMIC_RELAXED, __HIP_MEMORY_SCOPE_AGENT); m = chs[2 * j] + fmaxf(m, chs[2 * j + 1]); }
        __threadfence();
        __hip_atomic_store((unsigned*)(P.ws + WS_CTL) + 256 + l * 32 + b * 4 + h, 1u, __ATOMIC_RELEASE, __HIP_MEMORY_SCOPE_AGENT); }
    __syncthreads();
}
constexpr int MP_RQ = 0, MP_RK = 18240, MP_QS = 36480, MP_KS = 53888, MP_KT = 71296, MP_VT = 89728, MP_SC = 108160, MP_CW = 110016;
template <bool DRY> __device__ __forceinline__ void ml_pre(const Params& P, int l, int b, int h, int c, LAS unsigned char* lds, int tid) {
    asm volatile("" : "+v"(tid));
    const int lane = tid & 63, wid = __builtin_amdgcn_readfirstlane(tid >> 6), fr = lane & 15, fq = lane >> 4;
    LAS bf16* rawq = (LAS bf16*)(lds + MP_RQ); LAS bf16* rawk = (LAS bf16*)(lds + MP_RK); LAS bf16* qs = (LAS bf16*)(lds + MP_QS); LAS bf16* ks = (LAS bf16*)(lds + MP_KS);
    LAS bf16* kT = (LAS bf16*)(lds + MP_KT); LAS bf16* vT = (LAS bf16*)(lds + MP_VT);
    LAS float* chs = (LAS float*)(lds + MP_SC); LAS float* sc_a = chs + 64; LAS float* sc_M = sc_a + 64; LAS float* sc_inter = sc_a + 128; LAS float* sc_emt = sc_a + 192; LAS float* sc_wk = sc_a + 256; LAS float* rowsum = sc_a + 320;
    LAS float* cwq = (LAS float*)(lds + MP_CW); LAS float* cwk = cwq + 512; LAS float* cbq = cwq + 1024; LAS float* cbk = cwq + 1152;
    bf16* z = (bf16*)(P.ws + WS_BIG); const float* gates = (const float*)(P.ws + WS_GATES); const bf16* zhalo = (const bf16*)(P.ws + WS_ZHALO);
    bf16* mlw = (bf16*)(P.ws + WS_MLW); float* mls = (float*)(P.ws + WS_MLS);
    const int colq = 3072 + h * 128, colk = 3584 + h * 128, colv = 4096 + h * 128;
    const size_t rowb = (size_t)b * SEQ; const int t0 = c * 64; const int unit = (b * 4 + h) * 32 + c;
    const float ib = P.ml_i_bias[l * 4 + h], fb = P.ml_f_bias[l * 4 + h];
    { const float* w = P.ml_conv_w + (size_t)l * 4 * 1024; const float* bb = P.ml_conv_b + (size_t)l * 1024;
      const int j = tid >> 7, d = tid & 127; cwq[j * 128 + d] = w[j * 1024 + h * 128 + d]; cwk[j * 128 + d] = w[j * 1024 + 512 + h * 128 + d];
      if (tid < 128) { cbq[tid] = bb[h * 128 + tid]; cbk[tid] = bb[512 + h * 128 + tid]; }
      if (tid < 64) rowsum[tid] = 0.f; }
    { const int r = tid >> 3, c16 = (tid & 7) * 16; const bf16* zp = z + (rowb + t0 + r) * ZP;
      *(LAS v4u*)(rawq + (r + 3) * 136 + c16) = *(const v4u*)(zp + colq + c16); *(LAS v4u*)(rawq + (r + 3) * 136 + c16 + 8) = *(const v4u*)(zp + colq + c16 + 8);
      *(LAS v4u*)(rawk + (r + 3) * 136 + c16) = *(const v4u*)(zp + colk + c16); *(LAS v4u*)(rawk + (r + 3) * 136 + c16 + 8) = *(const v4u*)(zp + colk + c16 + 8);
      if (tid < 48) { const int hr = tid >> 4, pc = (tid & 15) * 8; v4u hq = (v4u){0u, 0u, 0u, 0u}, hk = hq;
          if (c > 0) { const bf16* hp = zhalo + ((size_t)(b * 32 + c - 1) * 3 + hr) * 1536 + h * 128 + pc; hq = *(const v4u*)(hp + 512); hk = *(const v4u*)(hp + 1024); }
          *(LAS v4u*)(rawq + hr * 136 + pc) = hq; *(LAS v4u*)(rawk + hr * 136 + pc) = hk; } }
    float pgi = 0.f, pgf = 0.f, m_run = 0.f;
    if (wid == 0) { const size_t row = rowb + t0 + lane; pgi = gates[row * 8 + h]; pgf = gates[row * 8 + 4 + h]; { unsigned* fl = (unsigned*)(P.ws + WS_CTL) + 256 + l * 32 + b * 4 + h; unsigned sp = 0;
            while (__hip_atomic_load(fl, __ATOMIC_RELAXED, __HIP_MEMORY_SCOPE_AGENT) == 0u && ++sp < (1u << 22)) __builtin_amdgcn_s_sleep(2);
            __builtin_amdgcn_fence(__ATOMIC_ACQUIRE, "agent"); }
          m_run = __hip_atomic_load((float*)(P.ws + WS_MCH) + (b * 4 + h) * 32 + c, __ATOMIC_RELAXED, __HIP_MEMORY_SCOPE_AGENT);
#if PROBE_SEL == 30
          { const int j_ = (int)(fabsf(m_run) * 1e-30f) & 31; const float m2_ = __hip_atomic_load((float*)(P.ws + WS_MCH) + (b * 4 + h) * 32 + j_, __ATOMIC_RELAXED, __HIP_MEMORY_SCOPE_AGENT); m_run += m2_ * 0.f; }
#endif
          }
    if (wid == 0) {
        const float li = pgi + ib, lf = logsigmoidf_(pgf + fb); const float bc = wave_incl_sum(lf);
        const float a = li - bc; const float cm = wave_incl_max(a);
        const float Mt = fmaxf(m_run, cm); const float M63 = __int_as_float(__builtin_amdgcn_readlane(__float_as_int(Mt), 63));
        const float inter = __expf(m_run - Mt), emt = __expf(-(bc + Mt));
        sc_a[lane] = a; sc_M[lane] = Mt; sc_inter[lane] = inter; sc_emt[lane] = emt; sc_wk[lane] = __expf(a - M63);
        mls[(size_t)unit * 256 + lane] = inter; mls[(size_t)unit * 256 + 64 + lane] = emt;
        if (lane == 0) mls[(size_t)unit * 256 + 192] = __expf(m_run - M63);
    }
    __syncthreads();
    {
        const int c16 = wid * 16; const float wkr = sc_wk[lane];
        float acc16[16];
#pragma unroll
        for (int i = 0; i < 16; ++i) acc16[i] = cbq[c16 + i];
#pragma unroll
        for (int j = 0; j < 4; ++j) { const v4u r0 = *(const LAS v4u*)(rawq + (lane + j) * 136 + c16), r1 = *(const LAS v4u*)(rawq + (lane + j) * 136 + c16 + 8);
            const unsigned w8[8] = {r0.x, r0.y, r0.z, r0.w, r1.x, r1.y, r1.z, r1.w};
#pragma unroll
            for (int i = 0; i < 8; ++i) { acc16[2 * i] += cwq[j * 128 + c16 + 2 * i] * bflo(w8[i]); acc16[2 * i + 1] += cwq[j * 128 + c16 + 2 * i + 1] * bfhi(w8[i]); } }
#pragma unroll
        for (int i = 0; i < 16; ++i) acc16[i] = acc16[i] * sigmoidf_(acc16[i]);
        v4u o;
        o.x = pk2(acc16[0], acc16[1]); o.y = pk2(acc16[2], acc16[3]); o.z = pk2(acc16[4], acc16[5]); o.w = pk2(acc16[6], acc16[7]); *(LAS v4u*)(qs + lane * 136 + c16) = o;
        o.x = pk2(acc16[8], acc16[9]); o.y = pk2(acc16[10], acc16[11]); o.z = pk2(acc16[12], acc16[13]); o.w = pk2(acc16[14], acc16[15]); *(LAS v4u*)(qs + lane * 136 + c16 + 8) = o;
#pragma unroll
        for (int i = 0; i < 16; ++i) acc16[i] = cbk[c16 + i];
#pragma unroll
        for (int j = 0; j < 4; ++j) { const v4u r0 = *(const LAS v4u*)(rawk + (lane + j) * 136 + c16), r1 = *(const LAS v4u*)(rawk + (lane + j) * 136 + c16 + 8);
            const unsigned w8[8] = {r0.x, r0.y, r0.z, r0.w, r1.x, r1.y, r1.z, r1.w};
#pragma unroll
            for (int i = 0; i < 8; ++i) { acc16[2 * i] += cwk[j * 128 + c16 + 2 * i] * bflo(w8[i]); acc16[2 * i + 1] += cwk[j * 128 + c16 + 2 * i + 1] * bfhi(w8[i]); } }
#pragma unroll
        for (int i = 0; i < 16; ++i) acc16[i] = acc16[i] * sigmoidf_(acc16[i]) * 0.08838834764831845f;
        o.x = pk2(acc16[0], acc16[1]); o.y = pk2(acc16[2], acc16[3]); o.z = pk2(acc16[4], acc16[5]); o.w = pk2(acc16[6], acc16[7]); *(LAS v4u*)(ks + lane * 136 + c16) = o;
        o.x = pk2(acc16[8], acc16[9]); o.y = pk2(acc16[10], acc16[11]); o.z = pk2(acc16[12], acc16[13]); o.w = pk2(acc16[14], acc16[15]); *(LAS v4u*)(ks + lane * 136 + c16 + 8) = o;
#pragma unroll
        for (int i = 0; i < 8; ++i) { const unsigned pw = pk2(acc16[2 * i] * wkr, acc16[2 * i + 1] * wkr); kT[(c16 + 2 * i) * 72 + lane] = (bf16)(pw & 0xffffu); kT[(c16 + 2 * i + 1) * 72 + lane] = (bf16)(pw >> 16); }
        const bf16* zp = z + (rowb + t0 + lane) * ZP + colv + c16;
        const v4u v0 = *(const v4u*)zp, v1 = *(const v4u*)(zp + 8);
        const unsigned vw[8] = {v0.x, v0.y, v0.z, v0.w, v1.x, v1.y, v1.z, v1.w};
#pragma unroll
        for (int i = 0; i < 8; ++i) { vT[(c16 + 2 * i) * 72 + lane] = (bf16)(vw[i] & 0xffffu); vT[(c16 + 2 * i + 1) * 72 + lane] = (bf16)(vw[i] >> 16); }
    }
    __syncthreads();
    {
        const int tt = wid >> 1, tq = 16 * tt + fr; const float Mt = sc_M[tq];
#pragma unroll
        for (int q2 = 0; q2 < 2; ++q2) {
            const int st = 2 * (wid & 1) + q2;
            v2u wv; wv.x = 0u; wv.y = 0u;
            if (st <= tt) {
                f32x4 acc = (f32x4){0.f, 0.f, 0.f, 0.f};
#pragma unroll
                for (int k4 = 0; k4 < 4; ++k4) { const bf16x8 a = *(const LAS bf16x8*)(ks + (16 * st + fr) * 136 + 32 * k4 + 8 * fq), bb = *(const LAS bf16x8*)(qs + tq * 136 + 32 * k4 + 8 * fq); acc = MFMA16(a, bb, acc); }
                const f32x4 av = *(const LAS f32x4*)(sc_a + 16 * st + 4 * fq);
                float w[4], rs = 0.f;
#pragma unroll
                for (int i = 0; i < 4; ++i) { const int s_ = 16 * st + 4 * fq + i; w[i] = (s_ <= tq) ? acc[i] * __expf(av[i] - Mt) : 0.f; rs += w[i]; }
                rs += __shfl_xor(rs, 16); rs += __shfl_xor(rs, 32);
                if (fq == 0) lds_addf(rowsum + tq, rs);
                wv.x = pk2(w[0], w[1]); wv.y = pk2(w[2], w[3]);
            }
            *(v2u*)(mlw + (size_t)unit * 4096 + tq * 64 + 16 * st + 4 * fq) = wv;
        }
        const int r = tid >> 3, c16 = (tid & 7) * 16; bf16* zp = z + (rowb + t0 + r) * ZP;
        if (!DRY) {
        *(v4u*)(zp + colq + c16) = *(const LAS v4u*)(qs + r * 136 + c16); *(v4u*)(zp + colq + c16 + 8) = *(const LAS v4u*)(qs + r * 136 + c16 + 8);
        const int d = 2 * r + (c16 >> 6), s0 = c16 & 63;
        *(v4u*)(zp + colk + c16) = *(const LAS v4u*)(kT + d * 72 + s0); *(v4u*)(zp + colk + c16 + 8) = *(const LAS v4u*)(kT + d * 72 + s0 + 8);
        *(v4u*)(zp + colv + c16) = *(const LAS v4u*)(vT + d * 72 + s0); *(v4u*)(zp + colv + c16 + 8) = *(const LAS v4u*)(vT + d * 72 + s0 + 8);
        { const int colo_ = 1536 + h * 128; const v4u o0 = *(const v4u*)(zp + colo_ + c16), o1 = *(const v4u*)(zp + colo_ + c16 + 8); const float* gp = P.ml_norm + l * 512 + h * 128 + c16;
          const unsigned ow8[8] = {o0.x, o0.y, o0.z, o0.w, o1.x, o1.y, o1.z, o1.w}; unsigned sg[8];
#pragma unroll
          for (int i = 0; i < 8; ++i) sg[i] = pk2(sigmoidf_(bflo(ow8[i])) * gp[2 * i], sigmoidf_(bfhi(ow8[i])) * gp[2 * i + 1]);
          *(v4u*)(zp + colo_ + c16) = (v4u){sg[0], sg[1], sg[2], sg[3]}; *(v4u*)(zp + colo_ + c16 + 8) = (v4u){sg[4], sg[5], sg[6], sg[7]}; }
        }
    }
    __syncthreads();
    if (tid < 64) mls[(size_t)unit * 256 + 128 + tid] = rowsum[tid];
    __syncthreads();
}
constexpr int MS_QS = 0, MS_KT = 17408, MS_VT = 35840, MS_W = 54272, MS_CT = 63488, MS_SC = 133120;
template <bool DRY> __device__ __forceinline__ void ml_seq(const Params& P, int l, int b, int h, LAS unsigned char* lds, int tid) {
    asm volatile("" : "+v"(tid));
    const int lane = tid & 63, wid = __builtin_amdgcn_readfirstlane(tid >> 6), fr = lane & 15, fq = lane >> 4;
    LAS bf16* qs = (LAS bf16*)(lds + MS_QS); LAS bf16* kT = (LAS bf16*)(lds + MS_KT); LAS bf16* vT = (LAS bf16*)(lds + MS_VT); LAS bf16* wsm = (LAS bf16*)(lds + MS_W); LAS bf16* CT0 = (LAS bf16*)(lds + MS_CT);
    LAS float* sc = (LAS float*)(lds + MS_SC);
    LAS float* qn = sc + 200; LAS float* ssq = sc + 264; LAS float* nvec = sc + 392; LAS float* gnl = sc + 520;
    bf16* z = (bf16*)(P.ws + WS_BIG); const bf16* mlw = (const bf16*)(P.ws + WS_MLW); const float* mls = (const float*)(P.ws + WS_MLS);
    const int colq = 3072 + h * 128, colk = 3584 + h * 128, colv = 4096 + h * 128, colo = 1536 + h * 128;
    const size_t rowb = (size_t)b * SEQ; const int unit0 = (b * 4 + h) * 32;
    if (tid < 128) { nvec[tid] = 0.f; gnl[tid] = P.ml_norm[l * 512 + h * 128 + tid]; ssq[tid] = 0.f; }
    for (int i = tid; i < 128 * 136 / 2; i += 512) ((LAS unsigned*)CT0)[i] = 0u;
    f32x4 Cacc[8];
#pragma unroll
    for (int i = 0; i < 8; ++i) Cacc[i] = (f32x4){0.f, 0.f, 0.f, 0.f};
    const int r = tid >> 3, c16 = (tid & 7) * 16;
    const int tt = wid >> 1, tq = 16 * tt + fr;
    v4u pq[2], pkt[2], pvt[2], pw; float ps = 0.f;
    v2u ow[4]; f32x4 hv[4];
#pragma unroll
    for (int i = 0; i < 4; ++i) { hv[i] = (f32x4){0.f, 0.f, 0.f, 0.f}; ow[i] = (v2u){0u, 0u}; }
#define MS_LOAD(CH) do { const bf16* zp = z + (rowb + (CH) * 64 + r) * ZP; \
        pq[0] = *(const v4u*)(zp + colq + c16); pq[1] = *(const v4u*)(zp + colq + c16 + 8); pkt[0] = *(const v4u*)(zp + colk + c16); pkt[1] = *(const v4u*)(zp + colk + c16 + 8); \
        pvt[0] = *(const v4u*)(zp + colv + c16); pvt[1] = *(const v4u*)(zp + colv + c16 + 8); pw = *(const v4u*)(mlw + (size_t)(unit0 + (CH)) * 4096 + tid * 8); \
        if (tid < 193) ps = mls[(size_t)(unit0 + (CH)) * 256 + tid]; } while (0)
#define MS_EMIT(CH) do { const float rn = 1.f / sqrtf(ssq[((CH) & 1) * 64 + tq] * (1.f / 128.f) + EPS); \
        bf16* zp = z + (rowb + (CH) * 64 + tq) * ZP + colo; \
        _Pragma("unroll") for (int q4 = 0; q4 < 4; ++q4) { const int e0 = 16 * (4 * (wid & 1) + q4) + 4 * fq; \
            const float y0 = hv[q4].x * rn * bflo(ow[q4].x), y1 = hv[q4].y * rn * bfhi(ow[q4].x); \
            const float y2 = hv[q4].z * rn * bflo(ow[q4].y), y3 = hv[q4].w * rn * bfhi(ow[q4].y); \
            v2u yo; yo.x = pk2(y0, y1); yo.y = pk2(y2, y3); if (DRY) yo = ow[q4]; *(v2u*)(zp + e0) = yo; } } while (0)
    MS_LOAD(0);
    __syncthreads();
    for (int ch = 0; ch < 32; ++ch) {
        const int t0 = ch * 64; const int par = ch & 1;
        LAS bf16* CTr = CT0 + par * (128 * 136); LAS bf16* CTw = CT0 + (par ^ 1) * (128 * 136);
        if (ch > 0) MS_EMIT(ch - 1);
        {
            *(LAS v4u*)(qs + r * 136 + c16) = pq[0]; *(LAS v4u*)(qs + r * 136 + c16 + 8) = pq[1];
            const int d = 2 * r + (c16 >> 6), s0 = c16 & 63;
            *(LAS v4u*)(kT + d * 72 + s0) = pkt[0]; *(LAS v4u*)(kT + d * 72 + s0 + 8) = pkt[1];
            *(LAS v4u*)(vT + d * 72 + s0) = pvt[0]; *(LAS v4u*)(vT + d * 72 + s0 + 8) = pvt[1];
            *(LAS v4u*)(wsm + r * 72 + (tid & 7) * 8) = pw;
            if (tid < 193) sc[tid] = ps;
            if (tid >= 256 && tid < 320) ssq[par * 64 + tid - 256] = 0.f;
            const unsigned qw[8] = {pq[0].x, pq[0].y, pq[0].z, pq[0].w, pq[1].x, pq[1].y, pq[1].z, pq[1].w};
            float qnp = 0.f;
#pragma unroll
            for (int i = 0; i < 8; ++i) qnp += bflo(qw[i]) * nvec[c16 + 2 * i] + bfhi(qw[i]) * nvec[c16 + 2 * i + 1];
            qnp += __shfl_xor(qnp, 1); qnp += __shfl_xor(qnp, 2); qnp += __shfl_xor(qnp, 4);
            if ((tid & 7) == 0) qn[r] = qnp;
        }
        if (ch + 1 < 32) MS_LOAD(ch + 1);
        { const bf16* zp = z + (rowb + t0 + tq) * ZP + colo;
#pragma unroll
          for (int q4 = 0; q4 < 4; ++q4) ow[q4] = *(const v2u*)(zp + 16 * (4 * (wid & 1) + q4) + 4 * fq); }
        LDS_BARRIER();
        {
            const float inter = sc[tq];
            const float den = inter * qn[tq] + sc[128 + tq];
            const float scl = __builtin_amdgcn_rcpf(fmaxf(fabsf(den), sc[64 + tq]));
            float ss = 0.f;
            bf16x8 qf[4], wf[2];
#pragma unroll
            for (int k4 = 0; k4 < 4; ++k4) qf[k4] = *(const LAS bf16x8*)(qs + tq * 136 + 32 * k4 + 8 * fq);
#pragma unroll
            for (int k2 = 0; k2 < 2; ++k2) wf[k2] = *(const LAS bf16x8*)(wsm + tq * 72 + 32 * k2 + 8 * fq);
            bf16x8 cf[4][4], vfr[4][2];
#pragma unroll
            for (int q4 = 0; q4 < 4; ++q4) { const int et = 4 * (wid & 1) + q4;
#pragma unroll
                for (int k4 = 0; k4 < 4; ++k4) cf[q4][k4] = *(const LAS bf16x8*)(CTr + (16 * et + fr) * 136 + 32 * k4 + 8 * fq);
#pragma unroll
                for (int k2 = 0; k2 < 2; ++k2) vfr[q4][k2] = *(const LAS bf16x8*)(vT + (16 * et + fr) * 72 + 32 * k2 + 8 * fq); }
            f32x4 acc4[4];
#pragma unroll
            for (int q4 = 0; q4 < 4; ++q4) acc4[q4] = (f32x4){0.f, 0.f, 0.f, 0.f};
#pragma unroll
            for (int k4 = 0; k4 < 4; ++k4)
#pragma unroll
                for (int q4 = 0; q4 < 4; ++q4) acc4[q4] = MFMA16(cf[q4][k4], qf[k4], acc4[q4]);
#pragma unroll
            for (int q4 = 0; q4 < 4; ++q4) acc4[q4] = acc4[q4] * inter;
#pragma unroll
            for (int k2 = 0; k2 < 2; ++k2)
#pragma unroll
                for (int q4 = 0; q4 < 4; ++q4) acc4[q4] = MFMA16(vfr[q4][k2], wf[k2], acc4[q4]);
#pragma unroll
            for (int q4 = 0; q4 < 4; ++q4) { hv[q4] = acc4[q4] * scl; ss += (hv[q4].x * hv[q4].x + hv[q4].y * hv[q4].y) + (hv[q4].z * hv[q4].z + hv[q4].w * hv[q4].w); }
            ss += __shfl_xor(ss, 16); ss += __shfl_xor(ss, 32);
            if (fq == 0) lds_addf(ssq + par * 64 + tq, ss);
        }
        {
            const float decay = sc[192];
            bf16x8 vf[2];
#pragma unroll
            for (int k2 = 0; k2 < 2; ++k2) vf[k2] = *(const LAS bf16x8*)(vT + (16 * wid + fr) * 72 + 32 * k2 + 8 * fq);
            bf16x8 kf[8][2];
#pragma unroll
            for (int dt = 0; dt < 8; ++dt)
#pragma unroll
                for (int k2 = 0; k2 < 2; ++k2) kf[dt][k2] = *(const LAS bf16x8*)(kT + (16 * dt + fr) * 72 + 32 * k2 + 8 * fq);
#pragma unroll
            for (int dt = 0; dt < 8; ++dt) Cacc[dt] = Cacc[dt] * decay;
#pragma unroll
            for (int k2 = 0; k2 < 2; ++k2)
#pragma unroll
                for (int dt = 0; dt < 8; ++dt) Cacc[dt] = MFMA16(kf[dt][k2], vf[k2], Cacc[dt]);
#pragma unroll
            for (int dt = 0; dt < 8; ++dt) { v2u cw; cw.x = pk2(Cacc[dt].x, Cacc[dt].y); cw.y = pk2(Cacc[dt].z, Cacc[dt].w);
                *(LAS v2u*)(CTw + (16 * wid + fr) * 136 + 16 * dt + 4 * fq) = cw; }
            { const int d = tid >> 2, qd = tid & 3; float s_ = 0.f;
#pragma unroll
                for (int j = 0; j < 2; ++j) { const v4u kk = *(const LAS v4u*)(kT + d * 72 + 16 * qd + 8 * j); s_ += (bflo(kk.x) + bfhi(kk.x)) + (bflo(kk.y) + bfhi(kk.y)) + (bflo(kk.z) + bfhi(kk.z)) + (bflo(kk.w) + bfhi(kk.w)); }
                s_ += __shfl_xor(s_, 1); s_ += __shfl_xor(s_, 2);
                if (qd == 0) nvec[d] = decay * nvec[d] + s_; }
        }
        LDS_BARRIER();
    }
    MS_EMIT(31);
#undef MS_LOAD
#undef MS_EMIT
}
constexpr int RP_RX = 0, RP_US = 18240, RP_A = 35648, RP_B = 35648 + 33792, RP_CW = 35648 + 2 * 33792, RP_P = 132;
template <bool DRY> __device__ __forceinline__ void rg_pre(const Params& P, int l, int b, int n, int cgp, LAS unsigned char* lds, int tid) {
    asm volatile("" : "+v"(tid));
    const int lane = tid & 63, wid = __builtin_amdgcn_readfirstlane(tid >> 6), fr = lane & 15, fq = lane >> 4;
    LAS bf16* rawx = (LAS bf16*)(lds + RP_RX); LAS bf16* us = (LAS bf16*)(lds + RP_US); LAS float* a_s = (LAS float*)(lds + RP_A); LAS float* b_s = (LAS float*)(lds + RP_B); LAS float* cw = (LAS float*)(lds + RP_CW); LAS float* cb = cw + 512;
    bf16* z = (bf16*)(P.ws + WS_BIG); const bf16* zhalo = (const bf16*)(P.ws + WS_ZHALO); bf16* rga = (bf16*)(P.ws + WS_RGA); float* rgsum = (float*)(P.ws + WS_RGSUM);
    const int colx = n * 128; const size_t rowb = (size_t)b * SEQ;
    { const float* w = P.rg_conv_w + (size_t)l * 4 * 512; const int j = tid >> 7, d = tid & 127; cw[j * 128 + d] = w[j * 512 + n * 128 + d]; if (tid < 128) cb[tid] = P.rg_conv_b[l * 512 + n * 128 + tid]; }
    bf16x8 Wr[4], Wi[4];
    { const float* wa = P.rg_wa + ((size_t)l * 4 + n) * 16384; const float* wx = P.rg_wx + ((size_t)l * 4 + n) * 16384; const int j = 16 * wid + fr;
#pragma unroll
      for (int k4 = 0; k4 < 4; ++k4) {
          unsigned pr[4], pi[4];
#pragma unroll
          for (int x2 = 0; x2 < 4; ++x2) { const int i0 = 32 * k4 + 8 * fq + 2 * x2; pr[x2] = pk2(wa[i0 * 128 + j], wa[(i0 + 1) * 128 + j]); pi[x2] = pk2(wx[i0 * 128 + j], wx[(i0 + 1) * 128 + j]); }
          Wr[k4] = __builtin_bit_cast(bf16x8, (v4u){pr[0], pr[1], pr[2], pr[3]}); Wi[k4] = __builtin_bit_cast(bf16x8, (v4u){pi[0], pi[1], pi[2], pi[3]}); } }
    float ba[4], bx[4], lsl[4];
#pragma unroll
    for (int i = 0; i < 4; ++i) { const int cc = l * 512 + n * 128 + 16 * wid + 4 * fq + i; ba[i] = P.rg_ba[cc]; bx[i] = P.rg_bx[cc]; lsl[i] = 8.f * logsigmoidf_(P.rg_lambda[cc]); }
    const int r = tid >> 3, c16r = (tid & 7) * 16;
    v4u px0, px1, phx = (v4u){0u, 0u, 0u, 0u};
#define RP_LOAD(C) do { const bf16* zp = z + (rowb + (C) * 64 + r) * ZP + colx + c16r; px0 = *(const v4u*)zp; px1 = *(const v4u*)(zp + 8); phx = (v4u){0u, 0u, 0u, 0u}; \
        if (tid < 48 && (C) > 0) phx = *(const v4u*)(zhalo + ((size_t)(b * 32 + (C) - 1) * 3 + (tid >> 4)) * 1536 + n * 128 + (tid & 15) * 8); } while (0)
    RP_LOAD(cgp * 4);
    for (int ci = 0; ci < 4; ++ci) {
        const int c = cgp * 4 + ci, t0 = c * 64;
        *(LAS v4u*)(rawx + (r + 3) * 136 + c16r) = px0; *(LAS v4u*)(rawx + (r + 3) * 136 + c16r + 8) = px1;
        if (tid < 48) *(LAS v4u*)(rawx + (tid >> 4) * 136 + (tid & 15) * 8) = phx;
        if (ci + 1 < 4) RP_LOAD(c + 1);
        LDS_BARRIER();
        { const int c16 = wid * 16; float au[16];
#pragma unroll
          for (int i = 0; i < 16; ++i) au[i] = cb[c16 + i];
#pragma unroll
          for (int j = 0; j < 4; ++j) { const v4u r0 = *(const LAS v4u*)(rawx + (lane + j) * 136 + c16), r1 = *(const LAS v4u*)(rawx + (lane + j) * 136 + c16 + 8);
              const unsigned xw[8] = {r0.x, r0.y, r0.z, r0.w, r1.x, r1.y, r1.z, r1.w};
#pragma unroll
              for (int i = 0; i < 8; ++i) { au[2 * i] += cw[j * 128 + c16 + 2 * i] * bflo(xw[i]); au[2 * i + 1] += cw[j * 128 + c16 + 2 * i + 1] * bfhi(xw[i]); } }
          v4u o;
          o.x = pk2(au[0], au[1]); o.y = pk2(au[2], au[3]); o.z = pk2(au[4], au[5]); o.w = pk2(au[6], au[7]); *(LAS v4u*)(us + lane * 136 + c16) = o;
          o.x = pk2(au[8], au[9]); o.y = pk2(au[10], au[11]); o.z = pk2(au[12], au[13]); o.w = pk2(au[14], au[15]); *(LAS v4u*)(us + lane * 136 + c16 + 8) = o; }
        LDS_BARRIER();
#if PROBE_SEL == 24
        if (!DRY)
#endif
#pragma unroll
        for (int tt = 0; tt < 4; ++tt) {
            f32x4 ar = (f32x4){0.f, 0.f, 0.f, 0.f}, ai = (f32x4){0.f, 0.f, 0.f, 0.f};
#pragma unroll
            for (int k4 = 0; k4 < 4; ++k4) { const bf16x8 bb = *(const LAS bf16x8*)(us + (16 * tt + fr) * 136 + 32 * k4 + 8 * fq); ar = MFMA16(Wr[k4], bb, ar); ai = MFMA16(Wi[k4], bb, ai); }
            const int t = 16 * tt + fr, c0 = 16 * wid + 4 * fq;
            const v2u uw = *(const LAS v2u*)(us + t * 136 + c0);
            const float uu[4] = {bflo(uw.x), bfhi(uw.x), bflo(uw.y), bfhi(uw.y)};
            f32x4 av, bv;
#pragma unroll
            for (int i = 0; i < 4; ++i) { const float rr = sigmoidf_(ar[i] + ba[i]), ii = sigmoidf_(ai[i] + bx[i]); const float la = rr * lsl[i]; av[i] = __expf(la);
                const float x2 = 2.f * la; const float poly = -x2 * (1.f + x2 * (0.5f + x2 * (0.16666667f + x2 * (0.041666668f + x2 * 0.0083333338f))));
                const float om = (x2 < -0.25f) ? 1.f - __expf(x2) : poly;
                bv[i] = __builtin_amdgcn_sqrtf(fmaxf(om, 0.f)) * ii * uu[i]; }
            *(LAS f32x4*)(a_s + t * RP_P + c0) = av; *(LAS f32x4*)(b_s + t * RP_P + c0) = bv;
        }
        LDS_BARRIER();
        { const int chn = tid & 127, qt = tid >> 7; LAS float* qsum = cw + 640;
          float hc = 0.f, ap = 1.f;
#pragma unroll
          for (int t = 0; t < 16; ++t) { const int tt_ = qt * 16 + t; const float a = a_s[tt_ * RP_P + chn]; hc = a * hc + b_s[tt_ * RP_P + chn]; ap *= a; b_s[tt_ * RP_P + chn] = hc; a_s[tt_ * RP_P + chn] = ap; }
          qsum[(qt * 128 + chn) * 2] = ap; qsum[(qt * 128 + chn) * 2 + 1] = hc;
          LDS_BARRIER();
          float hin_ = 0.f, ain_ = 1.f;
#pragma unroll
          for (int q = 0; q < 3; ++q) if (q < qt) { const float aq = qsum[(q * 128 + chn) * 2], hq = qsum[(q * 128 + chn) * 2 + 1]; hin_ = aq * hin_ + hq; ain_ *= aq; }
          if (qt > 0) {
#pragma unroll
              for (int t = 0; t < 16; ++t) { const int tt_ = qt * 16 + t; const float al = a_s[tt_ * RP_P + chn]; b_s[tt_ * RP_P + chn] += al * hin_; a_s[tt_ * RP_P + chn] = al * ain_; } }
          if (qt == 3) { float* sp = rgsum + ((size_t)(b * 32 + c) * 512 + n * 128 + chn) * 2; sp[0] = ap * ain_; sp[1] = hc + ap * hin_; } }
        LDS_BARRIER();
        { const size_t row = rowb + t0 + r; float hl[16], apv[16];
#pragma unroll
          for (int i = 0; i < 4; ++i) { const f32x4 x = *(const LAS f32x4*)(b_s + r * RP_P + c16r + 4 * i), y = *(const LAS f32x4*)(a_s + r * RP_P + c16r + 4 * i);
              hl[4 * i] = x.x; hl[4 * i + 1] = x.y; hl[4 * i + 2] = x.z; hl[4 * i + 3] = x.w; apv[4 * i] = y.x; apv[4 * i + 1] = y.y; apv[4 * i + 2] = y.z; apv[4 * i + 3] = y.w; }
          v4u o;
          o.x = pk2(hl[0], hl[1]); o.y = pk2(hl[2], hl[3]); o.z = pk2(hl[4], hl[5]); o.w = pk2(hl[6], hl[7]); if (!DRY) *(v4u*)(z + row * ZP + colx + c16r) = o;
          o.x = pk2(hl[8], hl[9]); o.y = pk2(hl[10], hl[11]); o.z = pk2(hl[12], hl[13]); o.w = pk2(hl[14], hl[15]); if (!DRY) *(v4u*)(z + row * ZP + colx + c16r + 8) = o;
          o.x = pk2(apv[0], apv[1]); o.y = pk2(apv[2], apv[3]); o.z = pk2(apv[4], apv[5]); o.w = pk2(apv[6], apv[7]); *(v4u*)(rga + row * 512 + colx + c16r) = o;
          o.x = pk2(apv[8], apv[9]); o.y = pk2(apv[10], apv[11]); o.z = pk2(apv[12], apv[13]); o.w = pk2(apv[14], apv[15]); *(v4u*)(rga + row * 512 + colx + c16r + 8) = o; }
        LDS_BARRIER();
    }
}
__device__ __forceinline__ void rg_scan(const Params& P, int b, int n, int tid) {
    asm volatile("" : "+v"(tid));
    if (tid < 128) {
        const float* rgsum = (const float*)(P.ws + WS_RGSUM); float* hin = (float*)(P.ws + WS_RGHIN);
        const int ch = n * 128 + tid; float h = 0.f;
        typedef float f32x2v_ __attribute__((ext_vector_type(2)));
        f32x2v_ sv[32];
#pragma unroll
        for (int c = 0; c < 32; ++c) sv[c] = *(const f32x2v_*)(rgsum + ((size_t)(b * 32 + c) * 512 + ch) * 2);
#pragma unroll
        for (int c = 0; c < 32; ++c) { hin[(size_t)(b * 32 + c) * 512 + ch] = h; h = sv[c].x * h + sv[c].y; }
    }
}

__global__ void __launch_bounds__(NWAVES * 64, 2) fwd_megakernel(Params P) {
    extern __shared__ __attribute__((aligned(16))) unsigned char lds_raw[];
    cg::grid_group grid = cg::this_grid();
    LAS unsigned char* lds = (LAS unsigned char*)lds_raw;
    volatile LAS unsigned* MISC = (volatile LAS unsigned*)(lds + MISC_OFF);
    if (threadIdx.x < 64) MISC[threadIdx.x] = 0u;
    __syncthreads();
    (void)xcd_barrier_post((unsigned*)(P.ws + WS_CTL) + 1024, MISC + 8);
#define SEAM() do { XcdBarrier xb_; xb_.bar = (unsigned*)(P.ws + WS_CTL) + 1024; xb_.x = xb_xcc_id(); xb_.st = (volatile LAS unsigned*)(lds + MISC_OFF) + 8; xcd_barrier(xb_); } while (0)
    const int G = gridDim.x, NGW = G * NWAVES;
#define FRESH() int tid = threadIdx.x; asm volatile("" : "+v"(tid)); const int lane = tid & 63, wave = __builtin_amdgcn_readfirstlane(tid >> 6), gw = blockIdx.x * NWAVES + wave; (void)lane; (void)gw
    unsigned char* ws = P.ws;
    unsigned* ctl = (unsigned*)(ws + WS_CTL);
    float* rstd = (float*)(ws + WS_RSTD); float* rgss = (float*)(ws + WS_RGSS); float* ssa = (float*)(ws + WS_SSA); (void)rstd; float* gates = (float*)(ws + WS_GATES); float* rope = (float*)(ws + WS_ROPE);
    bf16* xb = (bf16*)(ws + WS_XB); bf16* zb = (bf16*)(ws + WS_BIG);

#pragma unroll 1
    for (int l = 0; l < DEPTH; ++l) {
        const float* xin = (l == 0) ? P.x : P.out;
        if (l == 0) {
          { FRESH();
            convert_weights<0>(P, l, lds, gw, NGW, wave, lane);
            for (int i0 = 0; i0 < M * 8; i0 += G * 512) { const int i = i0 + blockIdx.x * 512 + tid; if (i >= M * 8) break; const int row = i >> 3, j = i & 7;
                const float inv = powf(500000.f, -(float)j * 0.125f); const float ang = (float)P.pos[row] * inv; float sn, cs; sincosf(ang, &sn, &cs);
                rope[(size_t)row * 16 + j] = cs; rope[(size_t)row * 16 + 8 + j] = sn; }
            rowpass<false>(xin, xb, ssa, nullptr, nullptr, gw, NGW, lane); }
          grid.sync();
        }
        { pg8::Gemm g{xb, (const bf16*)(ws + WS_WIN), M, ZP + 256, DM, DM}; pg8::StaticOrder S; S.init(M, ZP + 256, G, (int)blockIdx.x);
          pg8::EpiZ E{zb, ssa, rope, (bf16*)(ws + WS_ZHALO), gates};
#ifndef NO_G1
          pg8::gemm_phase<pg8::EpiZ, pg8::StaticOrder, true, true>(lds, g, S, E);
#if PROBE_SEL == 1
          pg8::gemm_phase<pg8::EpiZ, pg8::StaticOrder, true, true>(lds, g, S, E);
#endif
#endif
        }
        SEAM();
        {
            FRESH();
            for (int i0 = 0; i0 < M; i0 += G * 512) { const int i = i0 + blockIdx.x * 512 + tid; if (i < M) { rgss[i] = 0.f; ssa[i] = 0.f; } }
            for (int bh = (int)blockIdx.x; bh < 32; bh += G) ml_chain(P, l, bh >> 2, bh & 3, lds, tid);
            unsigned* cpre = ctl + l * 128 + 32;
#if PROBE_SEL == 21 || PROBE_SEL == 22 || PROBE_SEL == 23 || PROBE_SEL == 24 || PROBE_SEL == 25
            { unsigned* c2 = ctl + l * 128 + 100;
              for (;;) {
                if (tid == 0) MISC[0] = atomicAdd(c2, 1u);
                __syncthreads(); const unsigned u = MISC[0]; __syncthreads();
                if (u >= 1280u) break;
#if PROBE_SEL != 23
                if (u < 256u) rg_pre<true>(P, l, (int)(u >> 5), (int)((u >> 3) & 3), (int)(u & 7), lds, tid);
#endif
#if PROBE_SEL != 22 && PROBE_SEL != 24 && PROBE_SEL != 25
                if (u >= 256u) { const unsigned v = u - 256u; ml_pre<true>(P, l, (int)(v >> 7), (int)((v >> 5) & 3), (int)(v & 31), lds, tid); }
#endif
              }
              SEAM(); }
#endif
            for (;;) {
                if (tid == 0) MISC[0] = atomicAdd(cpre, 1u);
                __syncthreads(); const unsigned u = MISC[0]; __syncthreads();
                if (u >= 1280u) break;
                if (u < 256u) rg_pre<false>(P, l, (int)(u >> 5), (int)((u >> 3) & 3), (int)(u & 7), lds, tid);
                else { const unsigned v = u - 256u; ml_pre<false>(P, l, (int)(v >> 7), (int)((v >> 5) & 3), (int)(v & 31), lds, tid); }
            }
        }
        SEAM();
        {
            FRESH();
            unsigned* cseq = ctl + l * 128, *catt = ctl + l * 128 + 64;
#if PROBE_SEL == 20
            { unsigned* c2 = ctl + l * 128 + 96;
              for (;;) {
                if (tid == 0) MISC[0] = atomicAdd(c2, 1u);
                __syncthreads(); const unsigned u = MISC[0]; __syncthreads();
                if (u >= 32u) break;
                ml_seq<true>(P, l, (int)(u >> 2), (int)(u & 3), lds, tid); __syncthreads();
              }
              SEAM(); }
#endif
            for (;;) {
                if (tid == 0) MISC[0] = atomicAdd(cseq, 1u);
                __syncthreads(); const unsigned u = MISC[0]; __syncthreads();
                if (u >= 64u) break;
                if (u < 32u) ml_seq<false>(P, l, (int)(u >> 2), (int)(u & 3), lds, tid); else rg_scan(P, (int)((u - 32) >> 2), (int)((u - 32) & 3), tid);
                __syncthreads();
            }
            for (;;) {
                if (tid == 0) MISC[0] = atomicAdd(catt, 1u);
                __syncthreads(); const unsigned u = MISC[0]; __syncthreads();
                if (u >= 1024u) break;
                const int qb = 7 - (int)(u >> 7), rem = (int)(u & 127), b = rem >> 4, vh = rem & 15, hc = vh >> 1, e = vh & 1, hh = vh >> 2;
                attn_body::attn_unit<8>(b, qb, (const attn_body::bf16*)(zb + 1024 + hc * 64), (const attn_body::bf16*)(zb + 2048 + hc * 64), (const attn_body::bf16*)(zb + 2560 + hh * 128 + e * 64),
                                        (attn_body::bf16*)(xb + vh * 64), (char*)lds_raw);
            }
            { unsigned* ccv = ctl + l * 128 + 48;
              for (;;) {
                if (tid == 0) MISC[0] = atomicAdd(ccv, 1u);
                __syncthreads(); const unsigned u = MISC[0]; __syncthreads();
                if (u >= 624u) break;
                convert_weights<1>(P, l, lds, (int)u * NWAVES + wave, 1 << 30, wave, lane);
                __syncthreads();
              } }
        }
        SEAM();
        { FRESH(); finalize_mixers(P, l, gw, NGW, lane); }
        SEAM();
#if PROBE_SEL == 5
        for (int i = 0; i < 10; ++i) SEAM();
#endif
        { pg8::Gemm g{zb + 512, (const bf16*)(ws + WS_WOUT), M, DM, DMIX, ZP}; pg8::StaticOrder S; S.init(M, DM, G, (int)blockIdx.x);
          pg8::EpiResN E{xin, P.out, xb, rgss};
          pg8::gemm_phase<pg8::EpiResN, pg8::StaticOrder, true, true>(lds, g, S, E); }
        SEAM();
        { pg8::Gemm g{xb, (const bf16*)(ws + WS_WUP), M, UP, DM, DM}; pg8::StaticOrder S; S.init(M, UP, G, (int)blockIdx.x);
          pg8::EpiUG E{zb, rgss, (bf16*)(ws + WS_HALO), (bf16*)(ws + WS_UHEAD), P.ffn_conv_w + (size_t)l * 3 * UP, P.ffn_conv_b + (size_t)l * UP};
#ifndef NO_G4
          pg8::gemm_phase<pg8::EpiUG, pg8::StaticOrder, true, true>(lds, g, S, E);
#if PROBE_SEL == 2
          pg8::gemm_phase<pg8::EpiUG, pg8::StaticOrder, true, true>(lds, g, S, E);
#endif
#endif
          if (l + 1 < DEPTH) { FRESH();
              if (G == 256) { if (blockIdx.x >= 128) convert_weights<0>(P, l + 1, lds, ((int)blockIdx.x - 128) * NWAVES + wave, 128 * NWAVES, wave, lane); }
              else convert_weights<0>(P, l + 1, lds, gw, NGW, wave, lane); }
        }
        SEAM();
#ifndef NO_CG
        { FRESH(); conv_gate(P, l, tid, (int)blockIdx.x, 256, G); }
#endif
        SEAM();
        { pg8::Gemm g{zb, (const bf16*)(ws + WS_WDN), M, DM, DFF, DFF}; pg8::StaticOrder S; S.init(M, DM, G, (int)blockIdx.x);
          if (l + 1 < DEPTH) { pg8::EpiResN E{P.out, P.out, xb, ssa};
              pg8::gemm_phase<pg8::EpiResN, pg8::StaticOrder, true, true>(lds, g, S, E); }
          else { pg8::EpiResL E{P.out, P.out, xb, ssa};
              pg8::gemm_phase<pg8::EpiResL, pg8::StaticOrder, true, true>(lds, g, S, E); }
        }
        SEAM();
    }
    { FRESH(); final_norm(P, gw, NGW, lane, P.out); }
}

extern "C" void kernel_launch(void* const* d_in, const int* in_sizes, int n_in, void* d_out, int out_size, void* d_ws, size_t ws_size, hipStream_t stream) {
    static int grid_blocks = 0;
    if (grid_blocks == 0) {
        if (n_in != 26 || out_size != M * DM || ws_size < WS_END) { fprintf(stderr, "kernel_launch: unexpected shapes (n_in %d out %d ws %zu)\n", n_in, out_size, ws_size); grid_blocks = -1; return; }
        int dev = 0, cus = 0, per_cu = 0;
        hipGetDevice(&dev); hipDeviceGetAttribute(&cus, hipDeviceAttributeMultiprocessorCount, dev);
        if (hipFuncSetAttribute((const void*)fwd_megakernel, hipFuncAttributeMaxDynamicSharedMemorySize, LDS_BYTES) != hipSuccess) { fprintf(stderr, "kernel_launch: hipFuncSetAttribute failed\n"); grid_blocks = -1; return; }
        if (hipOccupancyMaxActiveBlocksPerMultiprocessor(&per_cu, (const void*)fwd_megakernel, NWAVES * 64, LDS_BYTES) != hipSuccess || per_cu < 1) { fprintf(stderr, "kernel_launch: occupancy query says %d\n", per_cu); per_cu = 1; (void)hipGetLastError(); }
        grid_blocks = cus * 1;
    }
    if (grid_blocks < 0) return;
    hipMemsetAsync((char*)d_ws + WS_CTL, 0, 32768, stream);
    Params p{};
    const void** pp = (const void**)&p;
    for (int i = 0; i < 26; ++i) pp[i] = d_in[i];
    p.out = (float*)d_out; p.ws = (unsigned char*)d_ws;
    void* args[] = {&p};
    hipError_t e = hipLaunchCooperativeKernel((const void*)fwd_megakernel, dim3(grid_blocks), dim3(NWAVES * 64), args, LDS_BYTES, stream);
    if (e != hipSuccess) fprintf(stderr, "cooperative launch failed: %s (grid %d)\n", hipGetErrorString(e), grid_blocks);
}
```

```cpp
#include <hip/hip_runtime.h>
#include <hip/hip_cooperative_groups.h>
#include <hip/hip_bf16.h>
#include <cstdio>
#include <cstdint>
#include <cmath>
namespace pg8 {
#define PG8_LAS __attribute__((address_space(3)))
typedef unsigned short bf16_t;
typedef short bf16x8 __attribute__((ext_vector_type(8)));
typedef float f32x4 __attribute__((ext_vector_type(4)));
typedef unsigned u32x4 __attribute__((ext_vector_type(4)));
constexpr int BM = 256, BK = 64, HALF = 128, HTB = HALF * BK * 2  , STAGE_BYTES = 8 * HTB, NXCD = 8, WGM = 8;

__host__ __device__ __forceinline__ int lds_byte(int r, int c) { const int st = (r >> 4) * 2 + (c >> 5), rr = r & 15, cc = c & 31, ob = rr * 64 + cc * 2; return st * 1024 + (ob ^ (((ob >> 9) & 1) << 5)); }
__host__ __device__ __forceinline__ void stage_rc(int b, int& R, int& C) { const int st = b / 1024, sb = b % 1024, swz = sb ^ (((sb >> 9) & 1) << 5); R = (st >> 1) * 16 + swz / 64; C = (st & 1) * 32 + (swz % 64) / 2; }
__host__ __device__ __forceinline__ int perm32(int rho) { const int n = rho >> 4, i = rho & 15; return 8 * (i >> 2) + 4 * n + (i & 3); }

struct Unit { int pm, pn; };
struct Gemm { const bf16_t* A; const bf16_t* Bt; int M, N, K, lda; };

struct StaticOrder {
    int nM, nN, nwg, G, c;
    __host__ __device__ void init(int M, int N, int G_, int c_) { nM = M / BM; nN = N / BM; nwg = nM * nN; G = G_; c = c_; }
    __host__ __device__ bool next(int i, Unit& u) const {
        const long L = (long)i * G + c; if (L >= nwg) return false;
        int wgid = (int)L; { const int q = nwg / NXCD, r = nwg % NXCD, xcd = wgid % NXCD, off = wgid / NXCD; wgid = (xcd < r ? xcd * (q + 1) : r * (q + 1) + (xcd - r) * q) + off; }
        const int nig = WGM * nN, gid = wgid / nig, fm = gid * WGM, gsz = (nM - fm) < WGM ? (nM - fm) : WGM;
        u.pm = fm + ((wgid % nig) % gsz); u.pn = (wgid % nig) / gsz; return true;
    }
    __device__ __forceinline__ void a_ready(const Unit&) const {}
    __device__ __forceinline__ void done(const Unit&) const {}
};

__device__ __forceinline__ unsigned cvt_pk_bf16(float lo, float hi) { unsigned r; asm volatile("v_cvt_pk_bf16_f32 %0, %1, %2" : "=v"(r) : "v"(lo), "v"(hi)); return r; }
typedef float f32x2 __attribute__((ext_vector_type(2)));

constexpr float QSCALE = 0.125f * 1.4426950408889634f;
constexpr int ZP = 4608, UP = 5632;
__device__ __forceinline__ u32x4 pack8(const f32x4 v0, const f32x4 v1) { u32x4 w; w.x = cvt_pk_bf16(v0[0], v0[1]); w.y = cvt_pk_bf16(v0[2], v0[3]); w.z = cvt_pk_bf16(v1[0], v1[1]); w.w = cvt_pk_bf16(v1[2], v1[3]); return w; }
struct EpiZ {
    static constexpr bool PERM = true, AFTER_DRAIN = false;
    bf16_t* Z; const float* rstd; const float* rope; bf16_t* zhalo; float* gates;
    __device__ __forceinline__ void operator()(const f32x4 (&acc)[2][2][4][2], const Unit& u, int wr, int wc, int fr, int fq) const {
        const int row0 = u.pm * BM + wr * 64 + fr, col0 = u.pn * BM + wc * 32 + 8 * fq;
        const bool isq = (u.pn == 4 || u.pn == 5), isk = (u.pn == 8 || u.pn == 9);
        const bool dorope = (isq || isk) && ((wc & 1) == 0);
        const float sc = isq ? QSCALE : 1.f;
        const int hblk = (u.pn < 2) ? 0 : (u.pn == 12 || u.pn == 13) ? 1 : (u.pn == 14 || u.pn == 15) ? 2 : -1;
        float rsv[2][4];
#pragma unroll
        for (int ai = 0; ai < 2; ++ai)
#pragma unroll
            for (int m = 0; m < 4; ++m) rsv[ai][m] = rstd[row0 + ai * HALF + m * 16];
        f32x4 rpn[4];
        if (dorope) { const f32x4* rp = (const f32x4*)(rope + (size_t)row0 * 16);
#pragma unroll
            for (int q = 0; q < 4; ++q) rpn[q] = rp[q]; }
#pragma unroll
        for (int ai = 0; ai < 2; ++ai) {
#pragma unroll
            for (int m = 0; m < 4; ++m) {
                const int row = row0 + ai * HALF + m * 16;
                f32x4 rpc[4];
                if (dorope) {
#pragma unroll
                    for (int q = 0; q < 4; ++q) rpc[q] = rpn[q];
                    if (ai * 4 + m < 7) { const int nrow = row0 + ((ai * 4 + m + 1) >> 2) * HALF + ((ai * 4 + m + 1) & 3) * 16; const f32x4* rp = (const f32x4*)(rope + (size_t)nrow * 16);
#pragma unroll
                        for (int q = 0; q < 4; ++q) rpn[q] = rp[q]; }
                }
                const float rs = sc * __builtin_amdgcn_rsqf(rsv[ai][m] * (1.f / 1024.f) + 1e-6f);
                f32x4 v[2][2];
#pragma unroll
                for (int bj = 0; bj < 2; ++bj)
#pragma unroll
                    for (int n = 0; n < 2; ++n) v[bj][n] = acc[ai][bj][m][n] * rs;
                if (dorope) {
                    const f32x4 c0 = rpc[0], c1 = rpc[1], s0 = rpc[2], s1 = rpc[3];
#pragma unroll
                    for (int bj = 0; bj < 2; ++bj) {
                        f32x4 p0, p1;
#pragma unroll
                        for (int i = 0; i < 4; ++i) { p0[i] = __shfl_xor(v[bj][0][i], 16); p1[i] = __shfl_xor(v[bj][1][i], 16); }
                        if (fq == 0) { v[bj][0] = v[bj][0] * c0 - p0 * s0; v[bj][1] = v[bj][1] * c1 - p1 * s1; }
                        else if (fq == 1) { v[bj][0] = v[bj][0] * c0 + p0 * s0; v[bj][1] = v[bj][1] * c1 + p1 * s1; }
                    }
                }
                if (u.pn == 18) { if (wc == 0 && fq == 0) { *(f32x4*)(gates + (size_t)row * 8) = v[0][0]; *(f32x4*)(gates + (size_t)row * 8 + 4) = v[0][1]; } continue; }
                bf16_t* rowp = Z + (size_t)row * ZP + col0;
#pragma unroll
                for (int bj = 0; bj < 2; ++bj) { const u32x4 w = pack8(v[bj][0], v[bj][1]); *(u32x4*)(rowp + bj * HALF) = w;
                    if (hblk >= 0 && m == 3 && fr >= 13) *(u32x4*)(zhalo + ((size_t)(row >> 6) * 3 + (fr - 13)) * 1536 + hblk * 512 + (u.pn & 1) * 256 + wc * 32 + 8 * fq + bj * HALF) = w; }
            }
        }
    }
};
struct EpiU {
    static constexpr bool PERM = true, AFTER_DRAIN = false;
    bf16_t* U; const float* rstd; bf16_t* halo;
    __device__ __forceinline__ void operator()(const f32x4 (&acc)[2][2][4][2], const Unit& u, int wr, int wc, int fr, int fq) const {
        const int row0 = u.pm * BM + wr * 64 + fr, col0 = u.pn * BM + wc * 32 + 8 * fq;
#pragma unroll
        for (int ai = 0; ai < 2; ++ai)
#pragma unroll
            for (int m = 0; m < 4; ++m) {
                const int row = row0 + ai * HALF + m * 16;
                const float rs = rstd[row];
                bf16_t* rowp = U + (size_t)row * UP + col0;
#pragma unroll
                for (int bj = 0; bj < 2; ++bj) {
                    const u32x4 w = pack8(acc[ai][bj][m][0] * rs, acc[ai][bj][m][1] * rs);
                    *(u32x4*)(rowp + bj * HALF) = w;
                    if (m == 3 && fr >= 14) *(u32x4*)(halo + ((size_t)(row >> 6) * 2 + (fr - 14)) * UP + col0 + bj * HALF) = w;
                }
            }
    }
};
struct EpiRes {
    static constexpr bool PERM = false, AFTER_DRAIN = false;
    const float* base; float* out;
    __device__ __forceinline__ void operator()(const f32x4 (&acc)[2][2][4][2], const Unit& u, int wr, int wc, int fr, int fq) const {
        const int col0 = u.pn * BM + wc * 32 + 4 * fq;
#pragma unroll
        for (int ai = 0; ai < 2; ++ai)
#pragma unroll
            for (int m = 0; m < 4; ++m) {
                const size_t off = (size_t)(u.pm * BM + ai * HALF + wr * 64 + m * 16 + fr) * 1024 + col0;
#pragma unroll
                for (int bj = 0; bj < 2; ++bj)
#pragma unroll
                    for (int n = 0; n < 2; ++n) { const f32x4 bs = *(const f32x4*)(base + off + bj * HALF + n * 16); *(f32x4*)(out + off + bj * HALF + n * 16) = bs + acc[ai][bj][m][n]; }
            }
    }
};

template <int CTRL> __device__ __forceinline__ float dppf_(float v) { return __int_as_float(__builtin_amdgcn_update_dpp(0, __float_as_int(v), CTRL, 0xf, 0xf, true)); }
#define DPPF(v, CTRL) dppf_<CTRL>(v)
struct EpiUG {
    static constexpr bool PERM = true, AFTER_DRAIN = false;
    bf16_t* H; const float* rstd; bf16_t* halo; bf16_t* uhead; const float* cw; const float* cb;
    __device__ __forceinline__ void operator()(const f32x4 (&acc)[2][2][4][2], const Unit& u, int wr, int wc, int fr, int fq) const {
        constexpr int DFF_ = 2816;
        const int ch0 = u.pn * 128 + wc * 32 + 8 * fq;
#pragma unroll
        for (int n = 0; n < 2; ++n) {
            const int ch = ch0 + 4 * n;
            const f32x4 wg0 = *(const f32x4*)(cw + ch), wg1 = *(const f32x4*)(cw + UP + ch), wg2 = *(const f32x4*)(cw + 2 * UP + ch), bg = *(const f32x4*)(cb + ch);
            const f32x4 wv0 = *(const f32x4*)(cw + DFF_ + ch), wv1 = *(const f32x4*)(cw + UP + DFF_ + ch), wv2 = *(const f32x4*)(cw + 2 * UP + DFF_ + ch), bv = *(const f32x4*)(cb + DFF_ + ch);
#pragma unroll
            for (int ai = 0; ai < 2; ++ai) {
                f32x4 pg = (f32x4){0.f, 0.f, 0.f, 0.f}, pv = pg;
                float rs4[4];
#pragma unroll
                for (int m = 0; m < 4; ++m) rs4[m] = rstd[u.pm * BM + ai * HALF + wr * 64 + m * 16 + fr];
#pragma unroll
                for (int m = 0; m < 4; ++m) {
                    const int row = u.pm * BM + ai * HALF + wr * 64 + m * 16 + fr;
                    const float rs = __builtin_amdgcn_rsqf(rs4[m] * (1.f / 1024.f) + 1e-6f);
                    const f32x4 g = acc[ai][0][m][n] * rs, v = acc[ai][1][m][n] * rs;
                    f32x4 g1, g2, v1, v2;
#pragma unroll
                    for (int i = 0; i < 4; ++i) {
                        g1[i] = DPPF(g[i], 0x111) + DPPF(pg[i], 0x10F); g2[i] = DPPF(g[i], 0x112) + DPPF(pg[i], 0x10E);
                        v1[i] = DPPF(v[i], 0x111) + DPPF(pv[i], 0x10F); v2[i] = DPPF(v[i], 0x112) + DPPF(pv[i], 0x10E);
                    }
                    const f32x4 cg = wg0 * g2 + wg1 * g1 + wg2 * g + bg, cv = wv0 * v2 + wv1 * v1 + wv2 * v + bv;
                    float hd[4];
#pragma unroll
                    for (int i = 0; i < 4; ++i) hd[i] = cg[i] * __builtin_amdgcn_rcpf(1.f + __expf(-cg[i])) * cv[i];
                    typedef unsigned u32x2_ __attribute__((ext_vector_type(2)));
                    u32x2_ w; w.x = cvt_pk_bf16(hd[0], hd[1]); w.y = cvt_pk_bf16(hd[2], hd[3]);
                    *(u32x2_*)(H + (size_t)row * DFF_ + ch) = w;
                    if ((m == 3 && fr >= 14) || (m == 0 && fr < 2)) {
                        u32x2_ rg, rv; rg.x = cvt_pk_bf16(g[0], g[1]); rg.y = cvt_pk_bf16(g[2], g[3]); rv.x = cvt_pk_bf16(v[0], v[1]); rv.y = cvt_pk_bf16(v[2], v[3]);
                        bf16_t* dst = (m == 3) ? halo + ((size_t)(row >> 6) * 2 + (fr - 14)) * UP : uhead + ((size_t)(row >> 6) * 2 + fr) * UP;
                        *(u32x2_*)(dst + ch) = rg; *(u32x2_*)(dst + DFF_ + ch) = rv;
                    }
                    pg = g; pv = v;
                }
            }
        }
    }
};

template <bool LAST> struct EpiResN_ {
    static constexpr bool PERM = false, AFTER_DRAIN = false;
    const float* base; float* out; bf16_t* xb; float* ssq;
    __device__ __forceinline__ void operator()(const f32x4 (&acc)[2][2][4][2], const Unit& u, int wr, int wc, int fr, int fq) const {
        typedef unsigned u32x2_ __attribute__((ext_vector_type(2)));
        const int col0 = u.pn * BM + wc * 32 + 4 * fq;
#pragma unroll
        for (int ai = 0; ai < 2; ++ai) {
            f32x4 pre[4][2][2];
#pragma unroll
            for (int m = 0; m < 4; ++m) { const size_t off = (size_t)(u.pm * BM + ai * HALF + wr * 64 + m * 16 + fr) * 1024 + col0;
#pragma unroll
                for (int bj = 0; bj < 2; ++bj)
#pragma unroll
                    for (int n = 0; n < 2; ++n) pre[m][bj][n] = *(const f32x4*)(base + off + bj * HALF + n * 16); }
            asm volatile("" ::: "memory");
#pragma unroll
            for (int m = 0; m < 4; ++m) {
                const int row = u.pm * BM + ai * HALF + wr * 64 + m * 16 + fr;
                const size_t off = (size_t)row * 1024 + col0; float ss = 0.f;
#pragma unroll
                for (int bj = 0; bj < 2; ++bj)
#pragma unroll
                    for (int n = 0; n < 2; ++n) { const f32x4 v = pre[m][bj][n] + acc[ai][bj][m][n]; *(f32x4*)(out + off + bj * HALF + n * 16) = v;
                        if (!LAST) { u32x2_ w; w.x = cvt_pk_bf16(v[0], v[1]); w.y = cvt_pk_bf16(v[2], v[3]); *(u32x2_*)(xb + off + bj * HALF + n * 16) = w;
                            ss += (v[0] * v[0] + v[1] * v[1]) + (v[2] * v[2] + v[3] * v[3]); } }
                if (!LAST) { ss += __shfl_xor(ss, 16); ss += __shfl_xor(ss, 32);
                    if (fq == 0) __hip_atomic_fetch_add(ssq + row, ss, __ATOMIC_RELAXED, __HIP_MEMORY_SCOPE_AGENT); }
            }
        }
    }
};
typedef EpiResN_<false> EpiResN;
typedef EpiResN_<true> EpiResL;

struct EpiResFinal {
    static constexpr bool PERM = false, AFTER_DRAIN = true;
    const float* base; float* out; float* ssq; unsigned* cnt; const float* gain;
    __device__ __forceinline__ void fused(f32x4 (&acc)[2][2][4][2], const Unit& u, int wr, int wc, int fr, int fq, PG8_LAS unsigned char* lds, int wid, int lane) const {
        const int col0 = u.pn * BM + wc * 32 + 4 * fq;
#pragma unroll
        for (int ai = 0; ai < 2; ++ai)
#pragma unroll
            for (int m = 0; m < 4; ++m) {
                const int row = u.pm * BM + ai * HALF + wr * 64 + m * 16 + fr;
                const size_t off = (size_t)row * 1024 + col0; float ss = 0.f;
#pragma unroll
                for (int bj = 0; bj < 2; ++bj)
#pragma unroll
                    for (int n = 0; n < 2; ++n) { const f32x4 v = *(const f32x4*)(base + off + bj * HALF + n * 16) + acc[ai][bj][m][n]; acc[ai][bj][m][n] = v;
                        ss += (v[0] * v[0] + v[1] * v[1]) + (v[2] * v[2] + v[3] * v[3]); }
                ss += __shfl_xor(ss, 16); ss += __shfl_xor(ss, 32);
                if (fq == 0) __hip_atomic_fetch_add(ssq + row, ss, __ATOMIC_RELAXED, __HIP_MEMORY_SCOPE_AGENT);
            }
        asm volatile("s_waitcnt vmcnt(0)" ::: "memory");
        __builtin_amdgcn_fence(__ATOMIC_RELEASE, "agent");
        if (lane == 0) __hip_atomic_fetch_add(cnt + 64 * u.pm, 1u, __ATOMIC_RELAXED, __HIP_MEMORY_SCOPE_AGENT);
        if (wid == 0) { unsigned sp = 0;
            while (__hip_atomic_load(cnt + 64 * u.pm, __ATOMIC_RELAXED, __HIP_MEMORY_SCOPE_AGENT) < 32u && ++sp < (1u << 22)) __builtin_amdgcn_s_sleep(2); }
        asm volatile("s_waitcnt vmcnt(0) lgkmcnt(0)" ::: "memory"); __builtin_amdgcn_s_barrier(); asm volatile("" ::: "memory");
        __builtin_amdgcn_fence(__ATOMIC_ACQUIRE, "agent");
        f32x4 gv[2][2];
#pragma unroll
        for (int bj = 0; bj < 2; ++bj)
#pragma unroll
            for (int n = 0; n < 2; ++n) gv[bj][n] = *(const f32x4*)(gain + col0 + bj * HALF + n * 16);
#pragma unroll
        for (int ai = 0; ai < 2; ++ai)
#pragma unroll
            for (int m = 0; m < 4; ++m) {
                const int row = u.pm * BM + ai * HALF + wr * 64 + m * 16 + fr;
                const size_t off = (size_t)row * 1024 + col0;
                const float r = __builtin_amdgcn_rsqf(__hip_atomic_load(ssq + row, __ATOMIC_RELAXED, __HIP_MEMORY_SCOPE_AGENT) * (1.f / 1024.f) + 1e-6f);
#pragma unroll
                for (int bj = 0; bj < 2; ++bj)
#pragma unroll
                    for (int n = 0; n < 2; ++n) *(f32x4*)(out + off + bj * HALF + n * 16) = acc[ai][bj][m][n] * r * gv[bj][n];
            }
    }
};
template <class Epi, class Sched, bool ALIGN_EPI = false, bool SP2 = false>
__device__ __forceinline__ void gemm_phase(PG8_LAS unsigned char* lds, const Gemm g, const Sched& S, const Epi& E) {
    int tid = threadIdx.x; asm volatile("" : "+v"(tid)); const int wid = __builtin_amdgcn_readfirstlane(tid >> 6), lane = tid & 63, wr = wid >> 2, wc = wid & 3, fr = lane & 15, fq = lane >> 4;
    const int K = g.K, nt = K / BK;
    unsigned voffA[2], voffB[2];
#pragma unroll
    for (int i = 0; i < 2; ++i) { int R, C; stage_rc(tid * 16 + i * 8192, R, C); const int Rb = Epi::PERM ? ((R & ~31) + perm32(R & 31)) : R;
        voffA[i] = (unsigned)(R * g.lda + C) * 2u; voffB[i] = (unsigned)(Rb * K + C) * 2u; }
    const size_t kstep = (size_t)(BK * 2);
    const size_t hstepB = (size_t)HALF * K * 2, hstepA = (size_t)HALF * g.lda * 2;
    const size_t tstepA = 2 * hstepA, tstepB = 2 * hstepB;
    const unsigned ldsw = (unsigned)wid * 1024u;
    const int aoff = lds_byte(wr * 64 + fr, fq * 8), boff = lds_byte(wc * 32 + fr, fq * 8);
#define PG8_SA(b, h) (((b) * 2 + (h)) * HTB)
#define PG8_SB(b, h) ((4 + (b) * 2 + (h)) * HTB)
#define PG8_STAGE(bufoff, gbase, voff) do { _Pragma("unroll") for (int _i = 0; _i < 2; ++_i) \
        __builtin_amdgcn_global_load_lds((const unsigned*)((const char*)(gbase) + (voff)[_i]), (PG8_LAS unsigned*)(lds + (bufoff) + ldsw + _i * 8192), 16, 0, 0); } while (0)
#define PG8_LDA(dst, b, h) do { _Pragma("unroll") for (int m = 0; m < 4; ++m) _Pragma("unroll") for (int k = 0; k < 2; ++k) dst[m][k] = *(const PG8_LAS bf16x8*)(lds + PG8_SA(b, h) + aoff + m * 2048 + k * 1024); } while (0)
#define PG8_LDB(dst, b, h) do { _Pragma("unroll") for (int n = 0; n < 2; ++n) _Pragma("unroll") for (int k = 0; k < 2; ++k) dst[n][k] = *(const PG8_LAS bf16x8*)(lds + PG8_SB(b, h) + boff + n * 2048 + k * 1024); } while (0)
#define PG8_MMA(ai, bj, At, Bt) do { __builtin_amdgcn_s_setprio(1); _Pragma("unroll") for (int m = 0; m < 4; ++m) _Pragma("unroll") for (int n = 0; n < 2; ++n) _Pragma("unroll") for (int k = 0; k < 2; ++k) \
        acc[ai][bj][m][n] = __builtin_amdgcn_mfma_f32_16x16x32_bf16(Bt[n][k], At[m][k], acc[ai][bj][m][n], 0, 0, 0); __builtin_amdgcn_s_setprio(0); } while (0)
#define PG8_WAIT_V(n) asm volatile("s_waitcnt vmcnt(" #n ")" ::: "memory")
#define PG8_WAIT_L(n) asm volatile("s_waitcnt lgkmcnt(" #n ")" ::: "memory")
#define PG8_BAR __builtin_amdgcn_s_barrier()
#define PG8_SCHED __builtin_amdgcn_sched_barrier(0)
    Unit cur, nxt; int ui = 0;
    if (!S.next(0, cur)) return;
    f32x4 acc[2][2][4][2];
#pragma unroll
    for (int a = 0; a < 2; ++a)
#pragma unroll
        for (int b = 0; b < 2; ++b)
#pragma unroll
            for (int m = 0; m < 4; ++m)
#pragma unroll
                for (int n = 0; n < 2; ++n) acc[a][b][m][n] = (f32x4){0.f, 0.f, 0.f, 0.f};
    bf16x8 At[4][2], B0[2][2], B1[2][2];
    const char* cA = (const char*)g.A + (size_t)cur.pm * tstepA; const char* cB = (const char*)g.Bt + (size_t)cur.pn * tstepB;
    S.a_ready(cur);
    if constexpr (SP2) {
        PG8_STAGE(PG8_SB(0, 0), cB, voffB); PG8_STAGE(PG8_SB(0, 1), cB + hstepB, voffB); PG8_STAGE(PG8_SA(0, 0), cA, voffA); PG8_STAGE(PG8_SA(0, 1), cA + hstepA, voffA);
        if (wr == 1) PG8_BAR;
        PG8_WAIT_V(2); PG8_BAR;
        PG8_STAGE(PG8_SB(1, 0), cB + kstep, voffB); PG8_STAGE(PG8_SA(1, 0), cA + kstep, voffA); PG8_STAGE(PG8_SB(1, 1), cB + hstepB + kstep, voffB);
        PG8_WAIT_V(6); PG8_BAR;
    } else {
        PG8_STAGE(PG8_SB(0, 0), cB, voffB); PG8_STAGE(PG8_SA(0, 0), cA, voffA); PG8_STAGE(PG8_SB(0, 1), cB + hstepB, voffB); PG8_STAGE(PG8_SA(0, 1), cA + hstepA, voffA);
        if (wr == 1) PG8_BAR;
        PG8_WAIT_V(4); PG8_BAR;
        PG8_STAGE(PG8_SB(1, 0), cB + kstep, voffB); PG8_STAGE(PG8_SA(1, 0), cA + kstep, voffA); PG8_STAGE(PG8_SB(1, 1), cB + hstepB + kstep, voffB);
        PG8_WAIT_V(6); PG8_BAR;
    }
    for (;;) {
        const bool has_next = S.next(ui + 1, nxt);
        const char* nA = has_next ? (const char*)g.A + (size_t)nxt.pm * tstepA : cA; const char* nB = has_next ? (const char*)g.Bt + (size_t)nxt.pn * tstepB : cB;
        for (int t = 0; t < nt; t += 2) {
            const bool last = (t == nt - 2);
            const char* a1 = cA + (size_t)(t + 1) * kstep;
            const char* a2 = last ? nA : cA + (size_t)(t + 2) * kstep; const char* b2 = last ? nB : cB + (size_t)(t + 2) * kstep;
            const char* a3 = a2 + kstep; const char* b3 = b2 + kstep;
            if (last && has_next) S.a_ready(nxt);
            if constexpr (SP2) {
            PG8_LDB(B0, 0, 0); PG8_LDB(B1, 0, 1); PG8_SCHED; PG8_LDA(At, 0, 0); PG8_STAGE(PG8_SA(1, 1), a1 + hstepA, voffA);
            PG8_WAIT_V(8); PG8_WAIT_L(0); PG8_BAR; PG8_MMA(0, 0, At, B0); PG8_MMA(0, 1, At, B1); PG8_BAR; PG8_SCHED;
            PG8_LDA(At, 0, 1); PG8_STAGE(PG8_SB(0, 0), b2, voffB); PG8_STAGE(PG8_SB(0, 1), b2 + hstepB, voffB); PG8_STAGE(PG8_SA(0, 0), a2, voffA);
            PG8_WAIT_V(8); PG8_WAIT_L(0); PG8_BAR; PG8_MMA(1, 0, At, B0); PG8_MMA(1, 1, At, B1); PG8_BAR; PG8_SCHED;
            PG8_LDB(B0, 1, 0); PG8_LDB(B1, 1, 1); PG8_SCHED; PG8_LDA(At, 1, 0); PG8_STAGE(PG8_SA(0, 1), a2 + hstepA, voffA);
            PG8_WAIT_V(8); PG8_WAIT_L(0); PG8_BAR; PG8_MMA(0, 0, At, B0); PG8_MMA(0, 1, At, B1); PG8_BAR; PG8_SCHED;
            PG8_LDA(At, 1, 1); PG8_STAGE(PG8_SB(1, 0), b3, voffB); PG8_STAGE(PG8_SB(1, 1), b3 + hstepB, voffB); PG8_STAGE(PG8_SA(1, 0), a3, voffA);
            PG8_WAIT_V(8); PG8_WAIT_L(0); PG8_BAR; PG8_MMA(1, 0, At, B0); PG8_MMA(1, 1, At, B1); PG8_BAR; PG8_SCHED;
            } else {
            PG8_LDB(B0, 0, 0); PG8_SCHED; PG8_LDA(At, 0, 0); PG8_STAGE(PG8_SA(1, 1), a1 + hstepA, voffA);
            PG8_WAIT_L(8); PG8_BAR; PG8_WAIT_L(0); PG8_MMA(0, 0, At, B0); PG8_BAR; PG8_SCHED;
            PG8_LDB(B1, 0, 1); PG8_STAGE(PG8_SB(0, 0), b2, voffB);
            PG8_BAR; PG8_WAIT_L(0); PG8_MMA(0, 1, At, B1); PG8_BAR;
            PG8_LDA(At, 0, 1); PG8_STAGE(PG8_SA(0, 0), a2, voffA);
            PG8_BAR; PG8_WAIT_L(0); PG8_MMA(1, 0, At, B0); PG8_BAR; PG8_SCHED;
            PG8_STAGE(PG8_SB(0, 1), b2 + hstepB, voffB);
            PG8_WAIT_V(6); PG8_BAR; PG8_MMA(1, 1, At, B1); PG8_BAR;
            PG8_LDB(B0, 1, 0); PG8_SCHED; PG8_LDA(At, 1, 0); PG8_STAGE(PG8_SA(0, 1), a2 + hstepA, voffA);
            PG8_WAIT_L(8); PG8_BAR; PG8_WAIT_L(0); PG8_MMA(0, 0, At, B0); PG8_BAR; PG8_SCHED;
            PG8_LDB(B1, 1, 1); PG8_STAGE(PG8_SB(1, 0), b3, voffB);
            PG8_BAR; PG8_WAIT_L(0); PG8_MMA(0, 1, At, B1); PG8_BAR;
            PG8_LDA(At, 1, 1); PG8_STAGE(PG8_SA(1, 0), a3, voffA);
            PG8_BAR; PG8_WAIT_L(0); PG8_MMA(1, 0, At, B0); PG8_BAR; PG8_SCHED;
            PG8_STAGE(PG8_SB(1, 1), b3 + hstepB, voffB);
            PG8_WAIT_V(6); PG8_BAR; PG8_MMA(1, 1, At, B1); PG8_BAR;
            }
        }
        if constexpr (ALIGN_EPI) { if (wr == 0) PG8_BAR; }
        if constexpr (!Epi::AFTER_DRAIN) { E(acc, cur, wr, wc, fr, fq); S.done(cur); }
        if (!has_next) break;
#pragma unroll
        for (int a = 0; a < 2; ++a)
#pragma unroll
            for (int b = 0; b < 2; ++b)
#pragma unroll
                for (int m = 0; m < 4; ++m)
#pragma unroll
                    for (int n = 0; n < 2; ++n) acc[a][b][m][n] = (f32x4){0.f, 0.f, 0.f, 0.f};
        cur = nxt; cA = nA; cB = nB; ++ui;
        if constexpr (ALIGN_EPI) { if (wr == 1) PG8_BAR; }
    }
    PG8_WAIT_V(0);
    if constexpr (!ALIGN_EPI) { if (wr == 0) PG8_BAR; }
    PG8_BAR;
    if constexpr (Epi::AFTER_DRAIN) { E.fused(acc, cur, wr, wc, fr, fq, lds, wid, lane); S.done(cur); }
#undef PG8_SA
#undef PG8_SB
#undef PG8_STAGE
#undef PG8_LDA
#undef PG8_LDB
#undef PG8_MMA
#undef PG8_WAIT_V
#undef PG8_WAIT_L
#undef PG8_BAR
#undef PG8_SCHED
}
}
#include <hip/hip_bf16.h>
#include <cmath>
namespace attn_body {
using bf16=__hip_bfloat16;
using bf16x8=__attribute__((ext_vector_type(8)))short;
using s16x4=__attribute__((ext_vector_type(4)))short;
using f32x16=__attribute__((ext_vector_type(16)))float;
using u32x4=__attribute__((ext_vector_type(4)))unsigned;
constexpr int BATCH=8,SEQ=2048,D=64,ZPI=4608,OPI=1024;
constexpr int NW=8,QBLK=32,QB=QBLK*NW,KVBLK=64,NQB=SEQ/QB;
constexpr int ATTN_UNIT_ROWS=QB;
__device__ __forceinline__ int crow(int r,int hi){return (r&3)+8*(r>>2)+4*hi;}
#define SBAR() __builtin_amdgcn_sched_barrier(0)
__device__ __forceinline__ void cmask(f32x16&p0,f32x16&p1,int jb,int qrel,int hi){
  const float NEG=-INFINITY; int kb=64*jb+4*hi;
  #pragma unroll
  for(int r=0;r<16;++r){int kv=kb+(r&3)+8*(r>>2); if(kv>qrel)p0[r]=NEG; if(kv+32>qrel)p1[r]=NEG;}
}

constexpr int NSLOT=3, SLOTB=8192;
constexpr int LDS_K=0, LDS_V=NSLOT*SLOTB, LDS_WS=2*NSLOT*SLOTB, LDS_OST=LDS_WS+NW*64*4, LDS_BYTES=LDS_OST+NW*4096;
constexpr float C2=0.125f*1.4426950408889634f;
__device__ __forceinline__ void glds16(const void*gsrc,unsigned lds_dst){unsigned keep;
  asm volatile("s_mov_b32 %0, m0\n\ts_mov_b32 m0, %2\n\ts_nop 0\n\tglobal_load_lds_dwordx4 %1, off\n\ts_mov_b32 m0, %0":"=&s"(keep):"v"(gsrc),"s"(lds_dst):"memory");}
__device__ __forceinline__ float max3f(float a,float b,float c){float r;asm("v_max3_f32 %0, %1, %2, %3":"=v"(r):"v"(a),"v"(b),"v"(c));return r;}
__device__ __forceinline__ float max2f(float a,float b){float r;asm("v_max_f32_e32 %0, %1, %2":"=v"(r):"v"(a),"v"(b));return r;}
__device__ __forceinline__ float fadd_s(float a,float b){float r;asm("v_add_f32_e32 %0, %1, %2":"=v"(r):"v"(a),"v"(b));return r;}
__device__ __forceinline__ float fsub_s(float a,float b){float r;asm("v_sub_f32_e32 %0, %1, %2":"=v"(r):"v"(a),"v"(b));return r;}
typedef float f32x2_t __attribute__((ext_vector_type(2))); typedef __bf16 bf16x2_t __attribute__((ext_vector_type(2)));
__device__ __forceinline__ unsigned cvtpk_s(float lo,float hi){f32x2_t v={lo,hi};bf16x2_t b=__builtin_convertvector(v,bf16x2_t);return __builtin_bit_cast(unsigned,b);}
#define WAIT_BAR(N) asm volatile("s_waitcnt vmcnt(" #N ") lgkmcnt(0)\n\ts_barrier":::"memory")

__device__ __forceinline__ void qkt(f32x16&p0,f32x16&p1,const char*Kslot,const bf16x8*qr,const f32x16&negm,int r32,int hi){
  const char*kb=Kslot+hi*1024+r32*16;
  #pragma unroll
  for(int d0=0;d0<4;++d0){
    const bf16x8 b0=*reinterpret_cast<const bf16x8*>(kb+d0*2048);
    const bf16x8 b1=*reinterpret_cast<const bf16x8*>(kb+d0*2048+512);
    if(d0==0){p0=__builtin_amdgcn_mfma_f32_32x32x16_bf16(b0,qr[0],negm,0,0,0);p1=__builtin_amdgcn_mfma_f32_32x32x16_bf16(b1,qr[0],negm,0,0,0);}
    else{p0=__builtin_amdgcn_mfma_f32_32x32x16_bf16(b0,qr[d0],p0,0,0,0);p1=__builtin_amdgcn_mfma_f32_32x32x16_bf16(b1,qr[d0],p1,0,0,0);}}
}
typedef __attribute__((address_space(3))) const char* lds_cptr;
typedef short v4i16_t __attribute__((ext_vector_type(4)));
__device__ __forceinline__ void kload8(bf16x8*kf,lds_cptr kp){
  kf[0]=*(const __attribute__((address_space(3))) bf16x8*)(kp);      kf[1]=*(const __attribute__((address_space(3))) bf16x8*)(kp+512);
  kf[2]=*(const __attribute__((address_space(3))) bf16x8*)(kp+2048); kf[3]=*(const __attribute__((address_space(3))) bf16x8*)(kp+2560);
  kf[4]=*(const __attribute__((address_space(3))) bf16x8*)(kp+4096); kf[5]=*(const __attribute__((address_space(3))) bf16x8*)(kp+4608);
  kf[6]=*(const __attribute__((address_space(3))) bf16x8*)(kp+6144); kf[7]=*(const __attribute__((address_space(3))) bf16x8*)(kp+6656);
}
__device__ __forceinline__ void kload2(bf16x8*kf,lds_cptr kp,int j){ kf[2*j]=*(const __attribute__((address_space(3))) bf16x8*)(kp+j*2048); kf[2*j+1]=*(const __attribute__((address_space(3))) bf16x8*)(kp+j*2048+512); }
__device__ __forceinline__ s16x4 vtr(lds_cptr p){ return __builtin_bit_cast(s16x4,__builtin_amdgcn_ds_read_tr16_b64_v4i16((__attribute__((address_space(3))) v4i16_t*)p)); }
__device__ __forceinline__ float rowmax(const f32x16&p0,const f32x16&p1){
  float a=max3f(p0[0],p0[1],p1[0]),b=max3f(p0[2],p0[3],p1[1]);a=max3f(a,p1[2],p1[3]);
  #pragma unroll
  for(int r=4;r<16;r+=4){a=max3f(a,p0[r],p0[r+1]);b=max3f(b,p0[r+2],p0[r+3]);a=max3f(a,p1[r],p1[r+1]);b=max3f(b,p1[r+2],p1[r+3]);}
  const float m=max2f(a,b);
  auto rr=__builtin_amdgcn_permlane32_swap(__float_as_uint(m),__float_as_uint(m),false,false);
  return max2f(__uint_as_float(rr[0]),__uint_as_float(rr[1]));
}
__device__ __forceinline__ void pv(f32x16*o,int vb,bf16x8 pa0,bf16x8 pa1,bf16x8 pa2,bf16x8 pa3){
  #pragma unroll
  for(int d0=0;d0<2;++d0){s16x4 lo[4],hi[4];
    #pragma unroll
    for(int ks=0;ks<4;++ks){
      asm volatile("ds_read_b64_tr_b16 %0,%1 offset:%c2":"=&v"(lo[ks]):"v"(vb),"i"(d0*4096+ks*1024):"memory");
      asm volatile("ds_read_b64_tr_b16 %0,%1 offset:%c2":"=&v"(hi[ks]):"v"(vb),"i"(d0*4096+ks*1024+512):"memory");}
    asm volatile("s_waitcnt lgkmcnt(0)":::"memory");SBAR();
    #define PK(k) (bf16x8){lo[k][0],lo[k][1],lo[k][2],lo[k][3],hi[k][0],hi[k][1],hi[k][2],hi[k][3]}
    o[d0]=__builtin_amdgcn_mfma_f32_32x32x16_bf16(pa0,PK(0),o[d0],0,0,0);
    o[d0]=__builtin_amdgcn_mfma_f32_32x32x16_bf16(pa1,PK(1),o[d0],0,0,0);
    o[d0]=__builtin_amdgcn_mfma_f32_32x32x16_bf16(pa2,PK(2),o[d0],0,0,0);
    o[d0]=__builtin_amdgcn_mfma_f32_32x32x16_bf16(pa3,PK(3),o[d0],0,0,0);
    #undef PK
  }
}

#ifndef ATTN_STORE16
#define ATTN_STORE16(p,v) (*(u32x4*)(p)=(v))
#endif
template<int THRL> __device__ __forceinline__ void attn_unit(int b,int qb,const bf16*Q,const bf16*__restrict__ K,const bf16*__restrict__ V,bf16*O,char*shm){
  int tid=threadIdx.x; asm volatile("":"+v"(tid)); const int lane=tid&63,r32=lane&31,hi=lane>>5; const int wid=__builtin_amdgcn_readfirstlane(tid>>6);
  const long rowbase=(long)b*SEQ; const int q0=qb*QB;
  const bf16*Qw=Q+(rowbase+q0+wid*QBLK)*ZPI;
  const bf16*Kh=K+rowbase*ZPI,*Vh=V+rowbase*ZPI;
  const unsigned lds0=(unsigned)(uintptr_t)shm;
  float*wsf=(float*)(shm+LDS_WS)+wid*64;
  const bf16*ksrc=Kh+(long)lane*ZPI+wid*8;
  const bf16*vsrc=Vh+(long)(16*(wid&3)+(lane>>2))*ZPI+(wid>>2)*32+(lane&3)*8;
  const unsigned kdst=lds0+LDS_K+wid*1024, vdst=lds0+LDS_V+wid*1024;
  #define DMA_K(t,slot) glds16(ksrc+(long)(t)*KVBLK*ZPI,(unsigned)__builtin_amdgcn_readfirstlane(kdst+(slot)))
  #define DMA_V(t,slot) glds16(vsrc+(long)(t)*KVBLK*ZPI,(unsigned)__builtin_amdgcn_readfirstlane(vdst+(slot)))
  const int vb0=(int)(lds0+LDS_V)+((lane>>4)&1)*32+(lane&3)*8+(4*hi+((lane&15)>>2))*64;
  const char*Kbase=shm+LDS_K; bf16x8 kf[8];
  const lds_cptr shm3=(lds_cptr)shm; const lds_cptr kp0=shm3+LDS_K+hi*1024+r32*16; const lds_cptr vp0=shm3+LDS_V+((lane>>4)&1)*32+(lane&3)*8+(4*hi+((lane&15)>>2))*64;
  const int NT=(q0+QB)/KVBLK;
  DMA_K(0,0);DMA_V(0,0);DMA_K(1,SLOTB);
  bf16x8 qr[4];
  #pragma unroll
  for(int d0=0;d0<4;++d0)qr[d0]=*reinterpret_cast<const bf16x8*>(&Qw[(long)r32*ZPI+d0*16+hi*8]);
  float mhat=0.f,l_reg=0.f;f32x16 o[2];o[0]=f32x16{};o[1]=f32x16{};f32x16 negm=f32x16{};asm volatile("":"+v"(negm));
  const int qrel=wid*QBLK+r32;
  #define CMASK(P0,P1,t) do{int jb_=(t)-(NT-4); if(jb_>=0)cmask(P0,P1,jb_,qrel,hi);}while(0)
  bool resc=false;
  #define START(P0,P1) do{ const float rm=rowmax(P0,P1); resc=false; \
    { const float dl=rm; mhat=fadd_s(mhat,dl); \
      _Pragma("unroll") for(int r=0;r<16;++r){P0[r]=fsub_s(P0[r],dl);P1[r]=fsub_s(P1[r],dl);} \
      _Pragma("unroll") for(int r=0;r<16;++r)negm[r]=-mhat; asm volatile("":"+v"(negm)); } \
    _Pragma("unroll") for(int r=0;r<16;++r)P0[r]=__builtin_amdgcn_exp2f(P0[r]); }while(0)
  #define RESC() do{ if(resc){ asm volatile("s_waitcnt lgkmcnt(0)":::"memory"); \
      _Pragma("unroll") for(int d_=0;d_<2;++d_) _Pragma("unroll") for(int r=0;r<16;++r)o[d_][r]*=wsf[crow(r,hi)]; } }while(0)
  f32x16 pA0,pA1,pB0,pB1;
  int sl_prev=0,sl_cur=0,sl_next=SLOTB;
  #define ROT() do{sl_prev=sl_cur;sl_cur=sl_next;sl_next=(sl_next==(NSLOT-1)*SLOTB)?0:sl_next+SLOTB;}while(0)
  DMA_K(2,2*SLOTB);
  WAIT_BAR(3);
  qkt(pA0,pA1,Kbase,qr,negm,r32,hi);asm volatile("s_nop 15\n\ts_nop 7":"+v"(pA0),"+v"(pA1));CMASK(pA0,pA1,0);
  START(pA0,pA1);
  _Pragma("unroll") for(int r=0;r<16;++r)pA1[r]=__builtin_amdgcn_exp2f(pA1[r]);
  WAIT_BAR(0);
  DMA_K(3,0);DMA_V(1,SLOTB);
  ROT();
  kload8(kf,kp0+sl_cur);
  WAIT_BAR(2);
  s16x4 vlo[8],vhi[8]; u32x4 pw0,pw1,pw2,pw3;
  #define PKW(P,B) cvtpk_s(P[B],P[B+1])
  #define PAF(k) __builtin_bit_cast(bf16x8,pw##k)
  #define VFR(i) (bf16x8){vlo[i][0],vlo[i][1],vlo[i][2],vlo[i][3],vhi[i][0],vhi[i][1],vhi[i][2],vhi[i][3]}
  #define PIN(x) asm volatile("":"+v"(x))
  #define MX3(a,b,c) __builtin_fmaxf(__builtin_fmaxf((a),(b)),(c))
  #define GAPA(MF,A0,A1,A2,A3,W0,W1,PW) do{ MF; sacc+=A0; sacc+=A1; sacc+=A2; sacc+=A3; PIN(sacc); W0; W1; PIN(PW); SBAR(); }while(0)
  #define EX(v) __builtin_amdgcn_exp2f(v)
  #define GAPB(MF,X,B) do{ MF; X[B]=EX(X[B]); X[B+1]=EX(X[B+1]); X[B+2]=EX(X[B+2]); X[B+3]=EX(X[B+3]); PIN(X); SBAR(); }while(0)
  #define VRD(i) do{ vlo[i]=vtr(vp_+(((i)>>2)*4096+((i)&3)*1024)); vhi[i]=vtr(vp_+(((i)>>2)*4096+((i)&3)*1024+512)); }while(0)
  #define KRD(G,j) do{ if(G){ kload2(kf,kp0+sl_next,j); SBAR(); } }while(0)
  #define STEP(C0,C1,P0,P1,t,GK,GV,GL) do{ SBAR(); \
    const lds_cptr vp_=vp0+sl_prev; \
    VRD(0); SBAR(); float sacc=(P0[0]+P0[1]); \
    GAPA(C0=__builtin_amdgcn_mfma_f32_32x32x16_bf16(kf[0],qr[0],negm,0,0,0), P0[2],P0[3],P0[4],P0[5],     pw0[0]=PKW(P0,0), pw0[1]=PKW(P0,2), pw0); \
    VRD(4); SBAR(); GAPA(C1=__builtin_amdgcn_mfma_f32_32x32x16_bf16(kf[1],qr[0],negm,0,0,0), P0[6],P0[7],P0[8],P0[9],     pw0[2]=PKW(P0,4), pw0[3]=PKW(P0,6), pw0); \
    VRD(1); SBAR(); GAPA(C0=__builtin_amdgcn_mfma_f32_32x32x16_bf16(kf[2],qr[1],C0,0,0,0),   P0[10],P0[11],P0[12],P0[13], pw1[0]=PKW(P0,8), pw1[1]=PKW(P0,10), pw1); \
    VRD(5); SBAR(); GAPA(C1=__builtin_amdgcn_mfma_f32_32x32x16_bf16(kf[3],qr[1],C1,0,0,0),   P0[14],P0[15],P1[0],P1[1],   pw1[2]=PKW(P0,12),pw1[3]=PKW(P0,14), pw1); \
    VRD(2); SBAR(); GAPA(C0=__builtin_amdgcn_mfma_f32_32x32x16_bf16(kf[4],qr[2],C0,0,0,0),   P1[2],P1[3],P1[4],P1[5],     pw2[0]=PKW(P1,0), pw2[1]=PKW(P1,2), pw2); \
    VRD(6); SBAR(); GAPA(C1=__builtin_amdgcn_mfma_f32_32x32x16_bf16(kf[5],qr[2],C1,0,0,0),   P1[6],P1[7],P1[8],P1[9],     pw2[2]=PKW(P1,4), pw2[3]=PKW(P1,6), pw2); \
    VRD(3); SBAR(); GAPA(C0=__builtin_amdgcn_mfma_f32_32x32x16_bf16(kf[6],qr[3],C0,0,0,0),   P1[10],P1[11],P1[12],P1[13], pw3[0]=PKW(P1,8), pw3[1]=PKW(P1,10), pw3); \
    VRD(7); SBAR(); GAPA(C1=__builtin_amdgcn_mfma_f32_32x32x16_bf16(kf[7],qr[3],C1,0,0,0),   P1[14],P1[15],0.f,0.f,       pw3[2]=PKW(P1,12),pw3[3]=PKW(P1,14), pw3); \
    l_reg+=sacc; \
    if(GK){DMA_K((t)+3,sl_cur);} if(GV){DMA_V((t)+1,sl_next);} \
    CMASK(C0,C1,t); \
    { float a=MX3(C0[0],C0[1],C1[0]),b=MX3(C0[2],C0[3],C1[1]); a=MX3(a,C1[2],C1[3]); \
      _Pragma("unroll") for(int r=4;r<16;r+=4){a=MX3(a,C0[r],C0[r+1]);b=MX3(b,C0[r+2],C0[r+3]);a=MX3(a,C1[r],C1[r+1]);b=MX3(b,C1[r+2],C1[r+3]);} \
      float rm=__builtin_fmaxf(a,b); { auto rr=__builtin_amdgcn_permlane32_swap(__float_as_uint(rm),__float_as_uint(rm),false,false); rm=__builtin_fmaxf(__uint_as_float(rr[0]),__uint_as_float(rr[1])); } \
      resc=false; \
      if(__builtin_expect(__any(rm>(float)THRL),0)){ const float dl=__builtin_fmaxf(rm,0.f); mhat+=dl; \
        _Pragma("unroll") for(int r=0;r<16;++r){C0[r]-=dl;C1[r]-=dl;} \
        _Pragma("unroll") for(int r=0;r<16;++r)negm[r]=-mhat; asm volatile("":"+v"(negm)); \
        const float f=__builtin_amdgcn_exp2f(-dl); l_reg*=f; if(hi==0)wsf[r32]=f; resc=true; } } \
    SBAR(); \
    GAPB(o[0]=__builtin_amdgcn_mfma_f32_32x32x16_bf16(PAF(0),VFR(0),o[0],0,0,0), C0,0); \
    GAPB(o[1]=__builtin_amdgcn_mfma_f32_32x32x16_bf16(PAF(0),VFR(4),o[1],0,0,0), C0,4); \
    KRD(GL,0); GAPB(o[0]=__builtin_amdgcn_mfma_f32_32x32x16_bf16(PAF(1),VFR(1),o[0],0,0,0), C0,8); \
    KRD(GL,1); GAPB(o[1]=__builtin_amdgcn_mfma_f32_32x32x16_bf16(PAF(1),VFR(5),o[1],0,0,0), C0,12); \
    KRD(GL,2); GAPB(o[0]=__builtin_amdgcn_mfma_f32_32x32x16_bf16(PAF(2),VFR(2),o[0],0,0,0), C1,0); \
    KRD(GL,3); GAPB(o[1]=__builtin_amdgcn_mfma_f32_32x32x16_bf16(PAF(2),VFR(6),o[1],0,0,0), C1,4); \
    GAPB(o[0]=__builtin_amdgcn_mfma_f32_32x32x16_bf16(PAF(3),VFR(3),o[0],0,0,0), C1,8); \
    GAPB(o[1]=__builtin_amdgcn_mfma_f32_32x32x16_bf16(PAF(3),VFR(7),o[1],0,0,0), C1,12); \
    }while(0)
  int t=1;
  #undef CMASK
  #define CMASK(P0,P1,t) do{}while(0)
  for(;t+5<NT;t+=2){
    STEP(pB0,pB1,pA0,pA1,t,true,true,true);     WAIT_BAR(2); RESC(); ROT();
    STEP(pA0,pA1,pB0,pB1,t+1,true,true,true);   WAIT_BAR(2); RESC(); ROT();
  }
  #undef CMASK
  #define CMASK(P0,P1,t) do{int jb_=(t)-(NT-4); if(jb_>=0)cmask(P0,P1,jb_,qrel,hi);}while(0)
  #define ENDW(tt) do{ if((tt)+3<NT){WAIT_BAR(2);} else if((tt)+2<NT){WAIT_BAR(1);} else {WAIT_BAR(0);} }while(0)
  for(;t+1<NT;t+=2){
    STEP(pB0,pB1,pA0,pA1,t,(t+3<NT),(t+1<NT),(t+1<NT));       ENDW(t);   RESC(); ROT();
    STEP(pA0,pA1,pB0,pB1,t+1,(t+4<NT),(t+2<NT),(t+2<NT));     ENDW(t+1); RESC(); ROT();
  }
  STEP(pB0,pB1,pA0,pA1,NT-1,false,false,false); RESC();
  { float sacc=pB0[0]+pB0[1]; _Pragma("unroll") for(int r=2;r<16;++r)sacc+=pB0[r]; _Pragma("unroll") for(int r=0;r<16;++r)sacc+=pB1[r]; l_reg+=sacc;
    pw0=(u32x4){PKW(pB0,0),PKW(pB0,2),PKW(pB0,4),PKW(pB0,6)};pw1=(u32x4){PKW(pB0,8),PKW(pB0,10),PKW(pB0,12),PKW(pB0,14)};pw2=(u32x4){PKW(pB1,0),PKW(pB1,2),PKW(pB1,4),PKW(pB1,6)};pw3=(u32x4){PKW(pB1,8),PKW(pB1,10),PKW(pB1,12),PKW(pB1,14)};
    SBAR(); pv(o,vb0+sl_cur,PAF(0),PAF(1),PAF(2),PAF(3)); }
  #undef PKW
  #undef PAF
  #undef VFR
  #undef PIN
  #undef MX3
  #undef GAPA
  #undef GAPB
  #undef EX
  #undef VRD
  #undef KRD
  #undef STEP
  #undef ENDW
  {auto rr=__builtin_amdgcn_permlane32_swap(__float_as_uint(l_reg),__float_as_uint(l_reg),false,false);l_reg=__uint_as_float(rr[0])+__uint_as_float(rr[1]);}
  if(hi==0)wsf[32+r32]=l_reg;asm volatile("s_waitcnt lgkmcnt(0)":::"memory");
  float rli[16];
  #pragma unroll
  for(int r=0;r<16;++r)rli[r]=__builtin_amdgcn_rcpf(wsf[32+crow(r,hi)]);
  bf16*Ow=O+(rowbase+q0+wid*QBLK)*OPI;
  { bf16*stg=(bf16*)(shm+LDS_OST)+wid*2048;
    #pragma unroll
    for(int r=0;r<16;++r){const int orow=crow(r,hi);
      #pragma unroll
      for(int d0=0;d0<2;++d0)stg[orow*64+d0*32+r32]=__float2bfloat16(o[d0][r]*rli[r]);}
    asm volatile("s_waitcnt lgkmcnt(0)":::"memory");
    #pragma unroll
    for(int i=0;i<4;++i){const int row=i*8+(lane>>3),ch=lane&7; const u32x4 v=*(const u32x4*)(stg+row*64+ch*8); ATTN_STORE16(Ow+(long)row*OPI+ch*8,v);} }
  asm volatile("s_waitcnt lgkmcnt(0)\n\ts_barrier":::"memory");
  #undef DMA_K
  #undef DMA_V
  #undef CMASK
  #undef START
  #undef RESC
  #undef ROT
}
constexpr int ATTN_LDS_BYTES=LDS_BYTES;
#undef SBAR
#undef WAIT_BAR
}

namespace cg = cooperative_groups;
#ifndef PROBE_SEL
#define PROBE_SEL 0
#endif
#define LAS __attribute__((address_space(3)))
typedef unsigned short bf16;
typedef unsigned v4u __attribute__((ext_vector_type(4)));
typedef unsigned v2u __attribute__((ext_vector_type(2)));
typedef float f32x4 __attribute__((ext_vector_type(4)));
typedef short bf16x8 __attribute__((ext_vector_type(8)));

constexpr int NWAVES = 8;
constexpr int M = 16384, DM = 1024, SEQ = 2048, NBATCH = 8, ZP = 4608, UP = 5632, DFF = 2816, DIN = 4616, DMIX = 1536;
constexpr int DEPTH = 2;
constexpr float EPS = 1e-6f;
constexpr size_t MiB = 1u << 20;
constexpr size_t WS_CTL = 0;
constexpr size_t WS_RSTD = 64 * 1024;
constexpr size_t WS_RGSS = 128 * 1024;
constexpr size_t WS_GATES = 1 * MiB;
constexpr size_t WS_ROPE = 2 * MiB;
constexpr size_t WS_HALO = 3 * MiB;
constexpr size_t WS_WIN = 9 * MiB;
constexpr size_t WS_WOUT = 18 * MiB + 512 * 1024;
constexpr size_t WS_WUP = 21 * MiB + 512 * 1024;
constexpr size_t WS_WDN = 32 * MiB + 512 * 1024;
constexpr size_t WS_SSA = 192 * 1024;
constexpr size_t WS_XB = 38 * MiB;
constexpr size_t WS_BIG = 70 * MiB;
constexpr size_t WS_UHEAD = 246 * MiB;
constexpr size_t WS_ZHALO = 252 * MiB;
constexpr size_t WS_MLW = WS_BIG + 144 * MiB;
constexpr size_t WS_MLS = WS_BIG + 152 * MiB;
constexpr size_t WS_RGA = WS_BIG + 153 * MiB;
constexpr size_t WS_RGSUM = WS_BIG + 169 * MiB;
constexpr size_t WS_RGHIN = WS_BIG + 170 * MiB;
constexpr size_t WS_MCH = WS_RGHIN + 768 * 1024;
constexpr size_t WS_END = 256 * MiB;
constexpr int LDS_BYTES = 147456, MISC_OFF = 147200;

struct Params {
    const float* x; const int* pos; const float* attn_norm; const float* w_in; const float* rg_conv_w; const float* rg_conv_b; const float* rg_wa; const float* rg_ba;
    const float* rg_wx; const float* rg_bx; const float* rg_lambda; const float* rg_norm; const float* da_lambda; const float* da_norm; const float* ml_conv_w; const float* ml_conv_b;
    const float* ml_i_bias; const float* ml_f_bias; const float* ml_norm; const float* w_out; const float* mlp_norm; const float* w_up; const float* ffn_conv_w; const float* ffn_conv_b;
    const float* w_down; const float* final_norm; float* out; unsigned char* ws;
};

__device__ __forceinline__ unsigned f2bf(float f) { unsigned u = __builtin_bit_cast(unsigned, f); return (u + 0x7fffu + ((u >> 16) & 1u)) >> 16; }
typedef float f32x2_t_ __attribute__((ext_vector_type(2))); typedef __bf16 bf16x2_t_ __attribute__((ext_vector_type(2)));
__device__ __forceinline__ unsigned pk2(float lo, float hi) { f32x2_t_ v = {lo, hi}; bf16x2_t_ b = __builtin_convertvector(v, bf16x2_t_); return __builtin_bit_cast(unsigned, b); }
__device__ __forceinline__ float bflo(unsigned w) { return __uint_as_float(w << 16); }
__device__ __forceinline__ float bfhi(unsigned w) { return __uint_as_float(w & 0xffff0000u); }
__device__ __forceinline__ float wave_sum(float v) {
#pragma unroll
    for (int o = 1; o < 64; o <<= 1) v += __shfl_xor(v, o);
    return v;
}
__device__ __forceinline__ float sigmoidf_(float x) { return __builtin_amdgcn_rcpf(1.f + __expf(-x)); }
__device__ __forceinline__ float logsigmoidf_(float x) { return fminf(x, 0.f) - log1pf(__expf(-fabsf(x))); }
__device__ __forceinline__ float gelu_tanh(float x) { const float y = 0.7978845608028654f * (x + 0.044715f * x * x * x); const float t = 1.f - 2.f * __builtin_amdgcn_rcpf(1.f + __expf(2.f * y)); return 0.5f * x * (1.f + t); }
__device__ __forceinline__ void lds_addf(LAS float* p, float v) { __hip_atomic_fetch_add(p, v, __ATOMIC_RELAXED, __HIP_MEMORY_SCOPE_WORKGROUP); }
template <int CTRL, int RM> __device__ __forceinline__ float dpp_old(float old, float v) { return __int_as_float(__builtin_amdgcn_update_dpp(__float_as_int(old), __float_as_int(v), CTRL, RM, 0xf, false)); }
__device__ __forceinline__ float wave_incl_sum(float v) {
    v += dpp_old<0x111, 0xf>(0.f, v); v += dpp_old<0x112, 0xf>(0.f, v); v += dpp_old<0x114, 0xf>(0.f, v); v += dpp_old<0x118, 0xf>(0.f, v);
    v += dpp_old<0x142, 0xa>(0.f, v); v += dpp_old<0x143, 0xc>(0.f, v); return v; }
__device__ __forceinline__ float wave_incl_max(float v) {
    const float ninf = -__builtin_inff();
    v = fmaxf(v, dpp_old<0x111, 0xf>(ninf, v)); v = fmaxf(v, dpp_old<0x112, 0xf>(ninf, v)); v = fmaxf(v, dpp_old<0x114, 0xf>(ninf, v)); v = fmaxf(v, dpp_old<0x118, 0xf>(ninf, v));
    v = fmaxf(v, dpp_old<0x142, 0xa>(ninf, v)); v = fmaxf(v, dpp_old<0x143, 0xc>(ninf, v)); return v; }
#define MFMA16(a, b, c) __builtin_amdgcn_mfma_f32_16x16x32_bf16((a), (b), (c), 0, 0, 0)
#define XB_TMO      128
#define XB_XCNT(j)  (256  + 64 * (j))
#define XB_XSUB(j)  (1280 + 64 * (j))
#define XB_XGEN(j)  (2304 + 64 * (j))
#define XB_TOP      3328
#define XB_TOPGEN   3392
#define XCD_BAR_WORDS 3456
#define XB_SPIN_CAP (1u << 18)

__device__ __forceinline__ unsigned xb_ld(unsigned* p)              { return __hip_atomic_load(p, __ATOMIC_RELAXED, __HIP_MEMORY_SCOPE_AGENT); }
__device__ __forceinline__ unsigned xb_add(unsigned* p, unsigned v) { return __hip_atomic_fetch_add(p, v, __ATOMIC_RELAXED, __HIP_MEMORY_SCOPE_AGENT); }
__device__ __forceinline__ unsigned xb_xcc_id() { return (unsigned)__builtin_amdgcn_s_getreg((3 << 11) | 20) & 0xFu; }
#define XB_SPIN(cond, bar) do { unsigned _sp = 0; while (cond) { __builtin_amdgcn_s_sleep(1); \
    if ((++_sp & 255u) == 0u) { if (xb_ld(&(bar)[XB_TMO])) break; if (_sp > XB_SPIN_CAP) { atomicAdd(&(bar)[XB_TMO], 1u); break; } } } } while (0)

struct XcdBarrier {
    unsigned* bar; unsigned x;
    volatile LAS unsigned* st;
};

__device__ __forceinline__ XcdBarrier xcd_barrier_post(unsigned* bar, volatile LAS unsigned* st) {
    XcdBarrier b; b.bar = bar; b.x = xb_xcc_id(); b.st = st;
    if (threadIdx.x == 0) (void)xb_add(&bar[XB_XCNT(b.x)], 1u);
    return b;
}
__device__ __forceinline__ void xcd_barrier_complete(unsigned* bar, unsigned x, unsigned& nloc, unsigned& nx) {
    const unsigned G = gridDim.x * gridDim.y * gridDim.z;
    unsigned sum, cnt, mine, sp = 0u;
    for (;;) {
        sum = 0u; cnt = 0u; mine = 0u;
#pragma unroll
        for (unsigned j = 0; j < 16; ++j) { const unsigned c = xb_ld(&bar[XB_XCNT(j)]); sum += c; cnt += (c > 0u) ? 1u : 0u; mine = (j == x) ? c : mine; }
        if (sum == G) break;
        __builtin_amdgcn_s_sleep(1);
        if ((++sp & 255u) == 0u) { if (xb_ld(&bar[XB_TMO])) break; if (sp > XB_SPIN_CAP) { atomicAdd(&bar[XB_TMO], 1u); break; } }
    }
    nloc = mine > 0u ? mine : 1u; nx = cnt > 0u ? cnt : 1u;
}

__device__ __forceinline__ void xcd_barrier(const XcdBarrier& b) {
    asm volatile("s_waitcnt vmcnt(0)" ::: "memory");
    __syncthreads();
    if (threadIdx.x == 0) {
        unsigned* bar = b.bar;
        __builtin_amdgcn_s_waitcnt(0);
        unsigned nloc = b.st[0], nx = b.st[1];
        if (nloc == 0u) { xcd_barrier_complete(bar, b.x, nloc, nx); b.st[0] = nloc; b.st[1] = nx; }
        const unsigned old = xb_add(&bar[XB_XSUB(b.x)], 1u);
        const unsigned gen = old / nloc;
        if (old + 1u == (gen + 1u) * nloc) {
            __builtin_amdgcn_fence(__ATOMIC_RELEASE, "agent");
            asm volatile("s_waitcnt vmcnt(0)" ::: "memory");
            const unsigned og = xb_add(&bar[XB_TOP], 1u);
            const unsigned tg = og / nx;
            if (og + 1u == (tg + 1u) * nx) xb_add(&bar[XB_TOPGEN], 1u);
            else XB_SPIN(xb_ld(&bar[XB_TOPGEN]) == tg, bar);
            __builtin_amdgcn_fence(__ATOMIC_ACQUIRE, "agent");
            xb_add(&bar[XB_XGEN(b.x)], 1u);
            asm volatile("s_waitcnt vmcnt(0)" ::: "memory");
        } else {
            XB_SPIN(xb_ld(&bar[XB_XGEN(b.x)]) == gen, bar);
            __builtin_amdgcn_fence(__ATOMIC_ACQUIRE, "agent");
            asm volatile("s_waitcnt vmcnt(0)" ::: "memory");
        }
    }
    __syncthreads();
}


__device__ __forceinline__ void transpose_item(const float* W, int ldw, int srccol, const float* gain, bf16* WT, int K, int dstrow, LAS float* scr, int k0, int lane, int nvalid = 32) {
    float tv[32];
#pragma unroll
    for (int i = 0; i < 32; ++i) { const int kk = 2 * i + (lane >> 5); tv[i] = ((lane & 31) < nvalid) ? W[(size_t)(k0 + kk) * ldw + srccol + (lane & 31)] : 0.f; }
    if (gain) {
#pragma unroll
        for (int i = 0; i < 32; ++i) tv[i] *= gain[k0 + 2 * i + (lane >> 5)]; }
#pragma unroll
    for (int i = 0; i < 32; ++i) scr[(2 * i + (lane >> 5)) * 33 + (lane & 31)] = tv[i];
    asm volatile("s_waitcnt lgkmcnt(0)" ::: "memory");
    const int c = lane & 7;
#pragma unroll
    for (int j = 0; j < 4; ++j) { const int n = (lane >> 3) + 8 * j; const LAS float* s = scr + (8 * c) * 33 + n;
        v4u o; o.x = pk2(s[0 * 33], s[1 * 33]); o.y = pk2(s[2 * 33], s[3 * 33]); o.z = pk2(s[4 * 33], s[5 * 33]); o.w = pk2(s[6 * 33], s[7 * 33]);
        *(v4u*)(WT + (size_t)(dstrow + n) * K + k0 + 8 * c) = o; }
    asm volatile("s_waitcnt lgkmcnt(0)" ::: "memory");
}
__device__ __forceinline__ int zcol_to_orig(int n0) {
    const int blk = n0 >> 9, r = n0 & 511;
    const int o = blk == 0 ? 0 : blk == 1 ? 512 : blk == 2 ? 1024 : blk == 3 ? 4096 : blk == 4 ? 1536 : blk == 5 ? 2048 : blk == 6 ? 2560 : blk == 7 ? 3072 : 3584;
    return o + r;
}
template <int PART> __device__ __forceinline__ void convert_weights(const Params& P, int l, LAS unsigned char* lds, int gw, int NGW, int wave, int lane) {
    LAS float* scr = (LAS float*)(lds + wave * 16384);
    constexpr int I_IN = 16 * 152, I_OUT = 24 * 32, I_UP = 16 * 176, I_DN = 44 * 32, NITEMS = I_IN + I_OUT + I_UP + I_DN;
    unsigned char* ws = P.ws;
    for (int it = (PART == 0 ? 0 : I_IN) + gw; it < (PART == 0 ? I_IN : NITEMS); it += NGW) {
        int r = it;
        if (r < I_IN) { const int kb = r / 152, nb = r % 152; transpose_item(P.w_in + (size_t)l * DM * DIN, DIN, nb < 144 ? zcol_to_orig(32 * nb) : 4608, P.attn_norm + l * DM, (bf16*)(ws + WS_WIN), DM, 32 * nb, scr, 64 * kb, lane, nb < 144 ? 32 : (nb == 144 ? 8 : 0)); continue; } r -= I_IN;
        if (r < I_OUT) { const int kb = r / 32, nb = r % 32; transpose_item(P.w_out + (size_t)l * DMIX * DM, DM, 32 * nb, nullptr, (bf16*)(ws + WS_WOUT), DMIX, 32 * nb, scr, 64 * kb, lane); continue; } r -= I_OUT;
        if (r < I_UP) { const int kb = r / 176, nb = r % 176; transpose_item(P.w_up + (size_t)l * DM * UP, UP, ((32 * nb) & 255) < 128 ? ((32 * nb) >> 8) * 128 + ((32 * nb) & 255) : DFF + ((32 * nb) >> 8) * 128 + ((32 * nb) & 255) - 128, P.mlp_norm + l * DM, (bf16*)(ws + WS_WUP), DM, 32 * nb, scr, 64 * kb, lane); continue; } r -= I_UP;
        { const int kb = r / 32, nb = r % 32; transpose_item(P.w_down + (size_t)l * DFF * DM, DM, 32 * nb, nullptr, (bf16*)(ws + WS_WDN), DFF, 32 * nb, scr, 64 * kb, lane); }
    }
}
template <bool GATES> __device__ __forceinline__ void rowpass(const float* x, bf16* xb, float* rstd, const LAS float* wgT, float* gates, int gw, int NGW, int lane) {
    for (int m = gw; m < M; m += 2 * NGW) {
        const int m2 = m + NGW; const bool has2 = m2 < M;
        const f32x4* xr = (const f32x4*)(x + (size_t)m * DM) + lane; const f32x4* xr2 = (const f32x4*)(x + (size_t)(has2 ? m2 : m) * DM) + lane;
        f32x4 v[4], w[4]; float s = 0.f, s2 = 0.f;
#pragma unroll
        for (int j = 0; j < 4; ++j) { v[j] = xr[64 * j]; w[j] = xr2[64 * j]; }
#pragma unroll
        for (int j = 0; j < 4; ++j) { s += (v[j].x * v[j].x + v[j].y * v[j].y) + (v[j].z * v[j].z + v[j].w * v[j].w); s2 += (w[j].x * w[j].x + w[j].y * w[j].y) + (w[j].z * w[j].z + w[j].w * w[j].w); }
        s = wave_sum(s); s2 = wave_sum(s2);
        if (lane == 0) { rstd[m] = s; if (has2) rstd[m2] = s2; }
        unsigned long long* o8 = (unsigned long long*)(xb + (size_t)m * DM) + lane;
#pragma unroll
        for (int j = 0; j < 4; ++j) o8[64 * j] = (unsigned long long)pk2(v[j].x, v[j].y) | ((unsigned long long)pk2(v[j].z, v[j].w) << 32);
        if (has2) { unsigned long long* p8 = (unsigned long long*)(xb + (size_t)m2 * DM) + lane;
#pragma unroll
            for (int j = 0; j < 4; ++j) p8[64 * j] = (unsigned long long)pk2(w[j].x, w[j].y) | ((unsigned long long)pk2(w[j].z, w[j].w) << 32); }
    }
}
__device__ __forceinline__ void finalize_mixers(const Params& P, int l, int gw, int NGW, int lane) {
    bf16* z = (bf16*)(P.ws + WS_BIG); const bf16* op = (const bf16*)(P.ws + WS_XB); const bf16* rga = (const bf16*)(P.ws + WS_RGA); const float* hin = (const float*)(P.ws + WS_RGHIN);
    const float lambda_init = 0.8f - 0.6f * expf(-0.3f * (float)l);
    const float* lp = P.da_lambda + l * 256;
    const float lam = expf(wave_sum(lp[lane] * lp[64 + lane])) - expf(wave_sum(lp[128 + lane] * lp[192 + lane])) + lambda_init;
    const float* gr = P.rg_norm + l * 512 + 8 * lane; const float* gd = P.da_norm + l * 128 + (lane & 15) * 8;
    float grg[8], gda[8];
#pragma unroll
    for (int i = 0; i < 8; ++i) { grg[i] = gr[i]; gda[i] = gd[i] * (1.f - lambda_init); }
    const int hh = lane >> 4, colw = (lane & 15) * 8, e = colw >> 6, d = colw & 63;
    v4u c_hw, c_aw, c_gw, c_a, c_b, n_hw, n_aw, n_gw, n_a, n_b; f32x4 c_h0, c_h1, n_h0, n_h1;
#define FM_LOAD(MM, HW, AW, GW, H0, H1, A_, B_) do { const bf16* zr_ = z + (size_t)(MM) * ZP; const int bb_ = (MM) >> 11, cc_ = ((MM) & 2047) >> 6; \
        HW = *(const v4u*)(zr_ + 8 * lane); AW = *(const v4u*)(rga + (size_t)(MM) * 512 + 8 * lane); GW = *(const v4u*)(zr_ + 512 + 8 * lane); \
        { const float* hp_ = hin + (size_t)(bb_ * 32 + cc_) * 512 + 8 * lane; H0 = *(const f32x4*)hp_; H1 = *(const f32x4*)(hp_ + 4); } \
        A_ = *(const v4u*)(op + (size_t)(MM) * DM + ((hh * 2 + 0) * 2 + e) * 64 + d); B_ = *(const v4u*)(op + (size_t)(MM) * DM + ((hh * 2 + 1) * 2 + e) * 64 + d); } while (0)
    if (gw < M) FM_LOAD(gw, c_hw, c_aw, c_gw, c_h0, c_h1, c_a, c_b);
    for (int m = gw; m < M; m += NGW) {
        bf16* zr = z + (size_t)m * ZP;
        const int mn = m + NGW;
        if (mn < M) FM_LOAD(mn, n_hw, n_aw, n_gw, n_h0, n_h1, n_a, n_b);
        { const v4u hw = c_hw, aw = c_aw, gw_ = c_gw; const f32x4 h0 = c_h0, h1 = c_h1;
          const float hl[8] = {bflo(hw.x), bfhi(hw.x), bflo(hw.y), bfhi(hw.y), bflo(hw.z), bfhi(hw.z), bflo(hw.w), bfhi(hw.w)};
          const float ap[8] = {bflo(aw.x), bfhi(aw.x), bflo(aw.y), bfhi(aw.y), bflo(aw.z), bfhi(aw.z), bflo(aw.w), bfhi(aw.w)};
          const float gt[8] = {bflo(gw_.x), bfhi(gw_.x), bflo(gw_.y), bfhi(gw_.y), bflo(gw_.z), bfhi(gw_.z), bflo(gw_.w), bfhi(gw_.w)};
          const float hi8[8] = {h0.x, h0.y, h0.z, h0.w, h1.x, h1.y, h1.z, h1.w};
          float y[8], ssum = 0.f;
#pragma unroll
          for (int i = 0; i < 8; ++i) { y[i] = gelu_tanh(gt[i]) * (hl[i] + ap[i] * hi8[i]); ssum += y[i] * y[i]; }
          ssum = wave_sum(ssum);
          const float rn = 1.f / sqrtf(ssum * (1.f / 512.f) + EPS); v4u o;
          o.x = pk2(y[0] * rn * grg[0], y[1] * rn * grg[1]); o.y = pk2(y[2] * rn * grg[2], y[3] * rn * grg[3]);
          o.z = pk2(y[4] * rn * grg[4], y[5] * rn * grg[5]); o.w = pk2(y[6] * rn * grg[6], y[7] * rn * grg[7]);
          *(v4u*)(zr + 512 + 8 * lane) = o; }
        { const v4u a = c_a, b = c_b; float o[8];
          o[0] = bflo(a.x) - lam * bflo(b.x); o[1] = bfhi(a.x) - lam * bfhi(b.x); o[2] = bflo(a.y) - lam * bflo(b.y); o[3] = bfhi(a.y) - lam * bfhi(b.y);
          o[4] = bflo(a.z) - lam * bflo(b.z); o[5] = bfhi(a.z) - lam * bfhi(b.z); o[6] = bflo(a.w) - lam * bflo(b.w); o[7] = bfhi(a.w) - lam * bfhi(b.w);
          float s_ = 0.f;
#pragma unroll
          for (int i = 0; i < 8; ++i) s_ += o[i] * o[i];
          s_ += __shfl_xor(s_, 1); s_ += __shfl_xor(s_, 2); s_ += __shfl_xor(s_, 4); s_ += __shfl_xor(s_, 8);
          const float rn = 1.f / sqrtf(s_ * (1.f / 128.f) + EPS); v4u w;
          w.x = pk2(o[0] * rn * gda[0], o[1] * rn * gda[1]); w.y = pk2(o[2] * rn * gda[2], o[3] * rn * gda[3]); w.z = pk2(o[4] * rn * gda[4], o[5] * rn * gda[5]); w.w = pk2(o[6] * rn * gda[6], o[7] * rn * gda[7]);
          *(v4u*)(zr + 1024 + hh * 128 + colw) = w; }
        c_hw = n_hw; c_aw = n_aw; c_gw = n_gw; c_h0 = n_h0; c_h1 = n_h1; c_a = n_a; c_b = n_b;
    }
#undef FM_LOAD
}
__device__ __forceinline__ void conv_gate(const Params& P, int l, int tid, int rc0, int rc1, int rcs) {
    asm volatile("" : "+v"(tid));
    bf16* H = (bf16*)(P.ws + WS_BIG); const bf16* halo = (const bf16*)(P.ws + WS_HALO); const bf16* uhead = (const bf16*)(P.ws + WS_UHEAD);
    const float* cw = P.ffn_conv_w + (size_t)l * 3 * UP; const float* cb = P.ffn_conv_b + (size_t)l * UP;
    for (int rc = rc0; rc < rc1; rc += rcs) {
        for (int p = tid; p < DFF / 2; p += NWAVES * 64) {
            const int c = 2 * p;
            float g[4][2], v[4][2];
#pragma unroll
            for (int q = 0; q < 2; ++q) { g[0][q] = 0.f; g[1][q] = 0.f; v[0][q] = 0.f; v[1][q] = 0.f; }
            if ((rc & 31) != 0) { const bf16* hp = halo + (size_t)(rc - 1) * 2 * UP;
                const unsigned a = *(const unsigned*)(hp + c), b = *(const unsigned*)(hp + UP + c), cc = *(const unsigned*)(hp + DFF + c), dd = *(const unsigned*)(hp + UP + DFF + c);
                g[0][0] = bflo(a); g[0][1] = bfhi(a); g[1][0] = bflo(b); g[1][1] = bfhi(b); v[0][0] = bflo(cc); v[0][1] = bfhi(cc); v[1][0] = bflo(dd); v[1][1] = bfhi(dd); }
            { const bf16* hp = uhead + (size_t)rc * 2 * UP;
                const unsigned a = *(const unsigned*)(hp + c), b = *(const unsigned*)(hp + UP + c), cc = *(const unsigned*)(hp + DFF + c), dd = *(const unsigned*)(hp + UP + DFF + c);
                g[2][0] = bflo(a); g[2][1] = bfhi(a); g[3][0] = bflo(b); g[3][1] = bfhi(b); v[2][0] = bflo(cc); v[2][1] = bfhi(cc); v[3][0] = bflo(dd); v[3][1] = bfhi(dd); }
#pragma unroll
            for (int t = 0; t < 2; ++t) { float hid[2];
#pragma unroll
                for (int q = 0; q < 2; ++q) { const float ug = cw[c + q] * g[t][q] + cw[UP + c + q] * g[t + 1][q] + cw[2 * UP + c + q] * g[t + 2][q] + cb[c + q];
                    const float uv = cw[DFF + c + q] * v[t][q] + cw[UP + DFF + c + q] * v[t + 1][q] + cw[2 * UP + DFF + c + q] * v[t + 2][q] + cb[DFF + c + q];
                    hid[q] = ug * sigmoidf_(ug) * uv; }
                *(unsigned*)(H + ((size_t)rc * 64 + t) * DFF + c) = pk2(hid[0], hid[1]); }
        }
    }
}
__device__ __forceinline__ void final_norm(const Params& P, int gw, int NGW, int lane, float* dst) {
    f32x4 g[4];
#pragma unroll
    for (int j = 0; j < 4; ++j) g[j] = ((const f32x4*)P.final_norm)[64 * j + lane];
    for (int m = gw; m < M; m += 2 * NGW) {
        const int m2 = m + NGW; const bool has2 = m2 < M;
        const f32x4* xr = (const f32x4*)(P.out + (size_t)m * DM) + lane; const f32x4* xr2 = (const f32x4*)(P.out + (size_t)(has2 ? m2 : m) * DM) + lane;
        f32x4 v[4], w[4]; float s = 0.f, s2 = 0.f;
#pragma unroll
        for (int j = 0; j < 4; ++j) { v[j] = xr[64 * j]; w[j] = xr2[64 * j]; }
#pragma unroll
        for (int j = 0; j < 4; ++j) { s += (v[j].x * v[j].x + v[j].y * v[j].y) + (v[j].z * v[j].z + v[j].w * v[j].w); s2 += (w[j].x * w[j].x + w[j].y * w[j].y) + (w[j].z * w[j].z + w[j].w * w[j].w); }
        s = wave_sum(s); s2 = wave_sum(s2);
        const float r = 1.f / sqrtf(s * (1.f / DM) + EPS), r2 = 1.f / sqrtf(s2 * (1.f / DM) + EPS);
        f32x4* dr = (f32x4*)(dst + (size_t)m * DM) + lane;
#pragma unroll
        for (int j = 0; j < 4; ++j) dr[64 * j] = v[j] * r * g[j];
        if (has2) { f32x4* dr2 = (f32x4*)(dst + (size_t)m2 * DM) + lane;
#pragma unroll
            for (int j = 0; j < 4; ++j) dr2[64 * j] = w[j] * r2 * g[j]; }
    }
}

__device__ __forceinline__ void ml_chain(const Params& P, int l, int b, int h, LAS unsigned char* lds, int tid) {
    asm volatile("" : "+v"(tid));
    const int lane = tid & 63, wid = __builtin_amdgcn_readfirstlane(tid >> 6);
    LAS float* chs = (LAS float*)lds; const float* gates = (const float*)(P.ws + WS_GATES); float* mch = (float*)(P.ws + WS_MCH);
    const float ib = P.ml_i_bias[l * 4 + h], fb = P.ml_f_bias[l * 4 + h];
    for (int j = wid; j < 32; j += 8) { const size_t row = (size_t)b * SEQ + j * 64 + lane;
        const float li = gates[row * 8 + h] + ib, lf = logsigmoidf_(gates[row * 8 + 4 + h] + fb);
        const float bc = wave_incl_sum(lf); const float am = wave_incl_max(li - bc);
        if (lane == 63) { chs[2 * j] = bc; chs[2 * j + 1] = am; } }
    __syncthreads();
    if (tid == 0) { float m = 0.f; for (int j = 0; j < 32; ++j) { __hip_atomic_store(mch + (b * 4 + h) * 32 + j, m, __ATOMIC_RELAXED, __HIP_MEMORY_SCOPE_AGENT); m = chs[2 * j] + fmaxf(m, chs[2 * j + 1]); }
        __threadfence();
        __hip_atomic_store((unsigned*)(P.ws + WS_CTL) + 256 + l * 32 + b * 4 + h, 1u, __ATOMIC_RELEASE, __HIP_MEMORY_SCOPE_AGENT); }
    __syncthreads();
}
constexpr int MP_RQ = 0, MP_RK = 18240, MP_QS = 36480, MP_KS = 53888, MP_KT = 71296, MP_VT = 89728, MP_SC = 108160, MP_CW = 110016;
template <bool DRY> __device__ __forceinline__ void ml_pre(const Params& P, int l, int b, int h, int c, LAS unsigned char* lds, int tid) {
    asm volatile("" : "+v"(tid));
    const int lane = tid & 63, wid = __builtin_amdgcn_readfirstlane(tid >> 6), fr = lane & 15, fq = lane >> 4;
    LAS bf16* rawq = (LAS bf16*)(lds + MP_RQ); LAS bf16* rawk = (LAS bf16*)(lds + MP_RK); LAS bf16* qs = (LAS bf16*)(lds + MP_QS); LAS bf16* ks = (LAS bf16*)(lds + MP_KS);
    LAS bf16* kT = (LAS bf16*)(lds + MP_KT); LAS bf16* vT = (LAS bf16*)(lds + MP_VT);
    LAS float* chs = (LAS float*)(lds + MP_SC); LAS float* sc_a = chs + 64; LAS float* sc_M = sc_a + 64; LAS float* sc_inter = sc_a + 128; LAS float* sc_emt = sc_a + 192; LAS float* sc_wk = sc_a + 256; LAS float* rowsum = sc_a + 320;
    LAS float* cwq = (LAS float*)(lds + MP_CW); LAS float* cwk = cwq + 512; LAS float* cbq = cwq + 1024; LAS float* cbk = cwq + 1152;
    bf16* z = (bf16*)(P.ws + WS_BIG); const float* gates = (const float*)(P.ws + WS_GATES); const bf16* zhalo = (const bf16*)(P.ws + WS_ZHALO);
    bf16* mlw = (bf16*)(P.ws + WS_MLW); float* mls = (float*)(P.ws + WS_MLS);
    const int colq = 3072 + h * 128, colk = 3584 + h * 128, colv = 4096 + h * 128;
    const size_t rowb = (size_t)b * SEQ; const int t0 = c * 64; const int unit = (b * 4 + h) * 32 + c;
    const float ib = P.ml_i_bias[l * 4 + h], fb = P.ml_f_bias[l * 4 + h];
    { const float* w = P.ml_conv_w + (size_t)l * 4 * 1024; const float* bb = P.ml_conv_b + (size_t)l * 1024;
      const int j = tid >> 7, d = tid & 127; cwq[j * 128 + d] = w[j * 1024 + h * 128 + d]; cwk[j * 128 + d] = w[j * 1024 + 512 + h * 128 + d];
      if (tid < 128) { cbq[tid] = bb[h * 128 + tid]; cbk[tid] = bb[512 + h * 128 + tid]; }
      if (tid < 64) rowsum[tid] = 0.f; }
    { const int r = tid >> 3, c16 = (tid & 7) * 16; const bf16* zp = z + (rowb + t0 + r) * ZP;
      *(LAS v4u*)(rawq + (r + 3) * 136 + c16) = *(const v4u*)(zp + colq + c16); *(LAS v4u*)(rawq + (r + 3) * 136 + c16 + 8) = *(const v4u*)(zp + colq + c16 + 8);
      *(LAS v4u*)(rawk + (r + 3) * 136 + c16) = *(const v4u*)(zp + colk + c16); *(LAS v4u*)(rawk + (r + 3) * 136 + c16 + 8) = *(const v4u*)(zp + colk + c16 + 8);
      if (tid < 48) { const int hr = tid >> 4, pc = (tid & 15) * 8; v4u hq = (v4u){0u, 0u, 0u, 0u}, hk = hq;
          if (c > 0) { const bf16* hp = zhalo + ((size_t)(b * 32 + c - 1) * 3 + hr) * 1536 + h * 128 + pc; hq = *(const v4u*)(hp + 512); hk = *(const v4u*)(hp + 1024); }
          *(LAS v4u*)(rawq + hr * 136 + pc) = hq; *(LAS v4u*)(rawk + hr * 136 + pc) = hk; } }
    float pgi = 0.f, pgf = 0.f, m_run = 0.f;
    if (wid == 0) { const size_t row = rowb + t0 + lane; pgi = gates[row * 8 + h]; pgf = gates[row * 8 + 4 + h]; { unsigned* fl = (unsigned*)(P.ws + WS_CTL) + 256 + l * 32 + b * 4 + h; unsigned sp = 0;
            while (__hip_atomic_load(fl, __ATOMIC_RELAXED, __HIP_MEMORY_SCOPE_AGENT) == 0u && ++sp < (1u << 22)) __builtin_amdgcn_s_sleep(2);
            __builtin_amdgcn_fence(__ATOMIC_ACQUIRE, "agent"); }
          m_run = __hip_atomic_load((float*)(P.ws + WS_MCH) + (b * 4 + h) * 32 + c, __ATOMIC_RELAXED, __HIP_MEMORY_SCOPE_AGENT);
#if PROBE_SEL == 30
          { const int j_ = (int)(fabsf(m_run) * 1e-30f) & 31; const float m2_ = __hip_atomic_load((float*)(P.ws + WS_MCH) + (b * 4 + h) * 32 + j_, __ATOMIC_RELAXED, __HIP_MEMORY_SCOPE_AGENT); m_run += m2_ * 0.f; }
#endif
          }
    if (wid == 0) {
        const float li = pgi + ib, lf = logsigmoidf_(pgf + fb); const float bc = wave_incl_sum(lf);
        const float a = li - bc; const float cm = wave_incl_max(a);
        const float Mt = fmaxf(m_run, cm); const float M63 = __int_as_float(__builtin_amdgcn_readlane(__float_as_int(Mt), 63));
        const float inter = __expf(m_run - Mt), emt = __expf(-(bc + Mt));
        sc_a[lane] = a; sc_M[lane] = Mt; sc_inter[lane] = inter; sc_emt[lane] = emt; sc_wk[lane] = __expf(a - M63);
        mls[(size_t)unit * 256 + lane] = inter; mls[(size_t)unit * 256 + 64 + lane] = emt;
        if (lane == 0) mls[(size_t)unit * 256 + 192] = __expf(m_run - M63);
    }
    __syncthreads();
    {
        const int c16 = wid * 16; const float wkr = sc_wk[lane];
        float acc16[16];
#pragma unroll
        for (int i = 0; i < 16; ++i) acc16[i] = cbq[c16 + i];
#pragma unroll
        for (int j = 0; j < 4; ++j) { const v4u r0 = *(const LAS v4u*)(rawq + (lane + j) * 136 + c16), r1 = *(const LAS v4u*)(rawq + (lane + j) * 136 + c16 + 8);
            const unsigned w8[8] = {r0.x, r0.y, r0.z, r0.w, r1.x, r1.y, r1.z, r1.w};
#pragma unroll
            for (int i = 0; i < 8; ++i) { acc16[2 * i] += cwq[j * 128 + c16 + 2 * i] * bflo(w8[i]); acc16[2 * i + 1] += cwq[j * 128 + c16 + 2 * i + 1] * bfhi(w8[i]); } }
#pragma unroll
        for (int i = 0; i < 16; ++i) acc16[i] = acc16[i] * sigmoidf_(acc16[i]);
        v4u o;
        o.x = pk2(acc16[0], acc16[1]); o.y = pk2(acc16[2], acc16[3]); o.z = pk2(acc16[4], acc16[5]); o.w = pk2(acc16[6], acc16[7]); *(LAS v4u*)(qs + lane * 136 + c16) = o;
        o.x = pk2(acc16[8], acc16[9]); o.y = pk2(acc16[10], acc16[11]); o.z = pk2(acc16[12], acc16[13]); o.w = pk2(acc16[14], acc16[15]); *(LAS v4u*)(qs + lane * 136 + c16 + 8) = o;
#pragma unroll
        for (int i = 0; i < 16; ++i) acc16[i] = cbk[c16 + i];
#pragma unroll
        for (int j = 0; j < 4; ++j) { const v4u r0 = *(const LAS v4u*)(rawk + (lane + j) * 136 + c16), r1 = *(const LAS v4u*)(rawk + (lane + j) * 136 + c16 + 8);
            const unsigned w8[8] = {r0.x, r0.y, r0.z, r0.w, r1.x, r1.y, r1.z, r1.w};
#pragma unroll
            for (int i = 0; i < 8; ++i) { acc16[2 * i] += cwk[j * 128 + c16 + 2 * i] * bflo(w8[i]); acc16[2 * i + 1] += cwk[j * 128 + c16 + 2 * i + 1] * bfhi(w8[i]); } }
#pragma unroll
        for (int i = 0; i < 16; ++i) acc16[i] = acc16[i] * sigmoidf_(acc16[i]) * 0.08838834764831845f;
        o.x = pk2(acc16[0], acc16[1]); o.y = pk2(acc16[2], acc16[3]); o.z = pk2(acc16[4], acc16[5]); o.w = pk2(acc16[6], acc16[7]); *(LAS v4u*)(ks + lane * 136 + c16) = o;
        o.x = pk2(acc16[8], acc16[9]); o.y = pk2(acc16[10], acc16[11]); o.z = pk2(acc16[12], acc16[13]); o.w = pk2(acc16[14], acc16[15]); *(LAS v4u*)(ks + lane * 136 + c16 + 8) = o;
#pragma unroll
        for (int i = 0; i < 8; ++i) { const unsigned pw = pk2(acc16[2 * i] * wkr, acc16[2 * i + 1] * wkr); kT[(c16 + 2 * i) * 72 + lane] = (bf16)(pw & 0xffffu); kT[(c16 + 2 * i + 1) * 72 + lane] = (bf16)(pw >> 16); }
        const bf16* zp = z + (rowb + t0 + lane) * ZP + colv + c16;
        const v4u v0 = *(const v4u*)zp, v1 = *(const v4u*)(zp + 8);
        const unsigned vw[8] = {v0.x, v0.y, v0.z, v0.w, v1.x, v1.y, v1.z, v1.w};
#pragma unroll
        for (int i = 0; i < 8; ++i) { vT[(c16 + 2 * i) * 72 + lane] = (bf16)(vw[i] & 0xffffu); vT[(c16 + 2 * i + 1) * 72 + lane] = (bf16)(vw[i] >> 16); }
    }
    __syncthreads();
    {
        const int tt = wid >> 1, tq = 16 * tt + fr; const float Mt = sc_M[tq];
#pragma unroll
        for (int q2 = 0; q2 < 2; ++q2) {
            const int st = 2 * (wid & 1) + q2;
            v2u wv; wv.x = 0u; wv.y = 0u;
            if (st <= tt) {
                f32x4 acc = (f32x4){0.f, 0.f, 0.f, 0.f};
#pragma unroll
                for (int k4 = 0; k4 < 4; ++k4) { const bf16x8 a = *(const LAS bf16x8*)(ks + (16 * st + fr) * 136 + 32 * k4 + 8 * fq), bb = *(const LAS bf16x8*)(qs + tq * 136 + 32 * k4 + 8 * fq); acc = MFMA16(a, bb, acc); }
                const f32x4 av = *(const LAS f32x4*)(sc_a + 16 * st + 4 * fq);
                float w[4], rs = 0.f;
#pragma unroll
                for (int i = 0; i < 4; ++i) { const int s_ = 16 * st + 4 * fq + i; w[i] = (s_ <= tq) ? acc[i] * __expf(av[i] - Mt) : 0.f; rs += w[i]; }
                rs += __shfl_xor(rs, 16); rs += __shfl_xor(rs, 32);
                if (fq == 0) lds_addf(rowsum + tq, rs);
                wv.x = pk2(w[0], w[1]); wv.y = pk2(w[2], w[3]);
            }
            *(v2u*)(mlw + (size_t)unit * 4096 + tq * 64 + 16 * st + 4 * fq) = wv;
        }
        const int r = tid >> 3, c16 = (tid & 7) * 16; bf16* zp = z + (rowb + t0 + r) * ZP;
        if (!DRY) {
        *(v4u*)(zp + colq + c16) = *(const LAS v4u*)(qs + r * 136 + c16); *(v4u*)(zp + colq + c16 + 8) = *(const LAS v4u*)(qs + r * 136 + c16 + 8);
        const int d = 2 * r + (c16 >> 6), s0 = c16 & 63;
        *(v4u*)(zp + colk + c16) = *(const LAS v4u*)(kT + d * 72 + s0); *(v4u*)(zp + colk + c16 + 8) = *(const LAS v4u*)(kT + d * 72 + s0 + 8);
        *(v4u*)(zp + colv + c16) = *(const LAS v4u*)(vT + d * 72 + s0); *(v4u*)(zp + colv + c16 + 8) = *(const LAS v4u*)(vT + d * 72 + s0 + 8);
        { const int colo_ = 1536 + h * 128; const v4u o0 = *(const v4u*)(zp + colo_ + c16), o1 = *(const v4u*)(zp + colo_ + c16 + 8); const float* gp = P.ml_norm + l * 512 + h * 128 + c16;
          const unsigned ow8[8] = {o0.x, o0.y, o0.z, o0.w, o1.x, o1.y, o1.z, o1.w}; unsigned sg[8];
#pragma unroll
          for (int i = 0; i < 8; ++i) sg[i] = pk2(sigmoidf_(bflo(ow8[i])) * gp[2 * i], sigmoidf_(bfhi(ow8[i])) * gp[2 * i + 1]);
          *(v4u*)(zp + colo_ + c16) = (v4u){sg[0], sg[1], sg[2], sg[3]}; *(v4u*)(zp + colo_ + c16 + 8) = (v4u){sg[4], sg[5], sg[6], sg[7]}; }
        }
    }
    __syncthreads();
    if (tid < 64) mls[(size_t)unit * 256 + 128 + tid] = rowsum[tid];
    __syncthreads();
}
constexpr int MS_QS = 0, MS_KT = 17408, MS_VT = 35840, MS_W = 54272, MS_CT = 63488, MS_SC = 133120;
template <bool DRY> __device__ __forceinline__ void ml_seq(const Params& P, int l, int b, int h, LAS unsigned char* lds, int tid) {
    asm volatile("" : "+v"(tid));
    const int lane = tid & 63, wid = __builtin_amdgcn_readfirstlane(tid >> 6), fr = lane & 15, fq = lane >> 4;
    LAS bf16* qs = (LAS bf16*)(lds + MS_QS); LAS bf16* kT = (LAS bf16*)(lds + MS_KT); LAS bf16* vT = (LAS bf16*)(lds + MS_VT); LAS bf16* wsm = (LAS bf16*)(lds + MS_W); LAS bf16* CT0 = (LAS bf16*)(lds + MS_CT);
    LAS float* sc = (LAS float*)(lds + MS_SC);
    LAS float* qn = sc + 200; LAS float* ssq = sc + 264; LAS float* nvec = sc + 392; LAS float* gnl = sc + 520;
    bf16* z = (bf16*)(P.ws + WS_BIG); const bf16* mlw = (const bf16*)(P.ws + WS_MLW); const float* mls = (const float*)(P.ws + WS_MLS);
    const int colq = 3072 + h * 128, colk = 3584 + h * 128, colv = 4096 + h * 128, colo = 1536 + h * 128;
    const size_t rowb = (size_t)b * SEQ; const int unit0 = (b * 4 + h) * 32;
    if (tid < 128) { nvec[tid] = 0.f; gnl[tid] = P.ml_norm[l * 512 + h * 128 + tid]; ssq[tid] = 0.f; }
    for (int i = tid; i < 128 * 136 / 2; i += 512) ((LAS unsigned*)CT0)[i] = 0u;
    f32x4 Cacc[8];
#pragma unroll
    for (int i = 0; i < 8; ++i) Cacc[i] = (f32x4){0.f, 0.f, 0.f, 0.f};
    const int r = tid >> 3, c16 = (tid & 7) * 16;
    const int tt = wid >> 1, tq = 16 * tt + fr;
    v4u pq[2], pkt[2], pvt[2], pw; float ps = 0.f;
    v2u ow[4]; f32x4 hv[4];
#pragma unroll
    for (int i = 0; i < 4; ++i) { hv[i] = (f32x4){0.f, 0.f, 0.f, 0.f}; ow[i] = (v2u){0u, 0u}; }
#define MS_LOAD(CH) do { const bf16* zp = z + (rowb + (CH) * 64 + r) * ZP; \
        pq[0] = *(const v4u*)(zp + colq + c16); pq[1] = *(const v4u*)(zp + colq + c16 + 8); pkt[0] = *(const v4u*)(zp + colk + c16); pkt[1] = *(const v4u*)(zp + colk + c16 + 8); \
        pvt[0] = *(const v4u*)(zp + colv + c16); pvt[1] = *(const v4u*)(zp + colv + c16 + 8); pw = *(const v4u*)(mlw + (size_t)(unit0 + (CH)) * 4096 + tid * 8); \
        if (tid < 193) ps = mls[(size_t)(unit0 + (CH)) * 256 + tid]; } while (0)
#define MS_EMIT(CH) do { const float rn = 1.f / sqrtf(ssq[((CH) & 1) * 64 + tq] * (1.f / 128.f) + EPS); \
        bf16* zp = z + (rowb + (CH) * 64 + tq) * ZP + colo; \
        _Pragma("unroll") for (int q4 = 0; q4 < 4; ++q4) { const int e0 = 16 * (4 * (wid & 1) + q4) + 4 * fq; \
            const float y0 = hv[q4].x * rn * bflo(ow[q4].x), y1 = hv[q4].y * rn * bfhi(ow[q4].x); \
            const float y2 = hv[q4].z * rn * bflo(ow[q4].y), y3 = hv[q4].w * rn * bfhi(ow[q4].y); \
            v2u yo; yo.x = pk2(y0, y1); yo.y = pk2(y2, y3); if (DRY) yo = ow[q4]; *(v2u*)(zp + e0) = yo; } } while (0)
    MS_LOAD(0);
    __syncthreads();
    for (int ch = 0; ch < 32; ++ch) {
        const int t0 = ch * 64; const int par = ch & 1;
        LAS bf16* CTr = CT0 + par * (128 * 136); LAS bf16* CTw = CT0 + (par ^ 1) * (128 * 136);
        if (ch > 0) MS_EMIT(ch - 1);
        {
            *(LAS v4u*)(qs + r * 136 + c16) = pq[0]; *(LAS v4u*)(qs + r * 136 + c16 + 8) = pq[1];
            const int d = 2 * r + (c16 >> 6), s0 = c16 & 63;
            *(LAS v4u*)(kT + d * 72 + s0) = pkt[0]; *(LAS v4u*)(kT + d * 72 + s0 + 8) = pkt[1];
            *(LAS v4u*)(vT + d * 72 + s0) = pvt[0]; *(LAS v4u*)(vT + d * 72 + s0 + 8) = pvt[1];
            *(LAS v4u*)(wsm + r * 72 + (tid & 7) * 8) = pw;
            if (tid < 193) sc[tid] = ps;
            if (tid >= 256 && tid < 320) ssq[par * 64 + tid - 256] = 0.f;
            const unsigned qw[8] = {pq[0].x, pq[0].y, pq[0].z, pq[0].w, pq[1].x, pq[1].y, pq[1].z, pq[1].w};
            float qnp = 0.f;
#pragma unroll
            for (int i = 0; i < 8; ++i) qnp += bflo(qw[i]) * nvec[c16 + 2 * i] + bfhi(qw[i]) * nvec[c16 + 2 * i + 1];
            qnp += __shfl_xor(qnp, 1); qnp += __shfl_xor(qnp, 2); qnp += __shfl_xor(qnp, 4);
            if ((tid & 7) == 0) qn[r] = qnp;
        }
        if (ch + 1 < 32) MS_LOAD(ch + 1);
        { const bf16* zp = z + (rowb + t0 + tq) * ZP + colo;
#pragma unroll
          for (int q4 = 0; q4 < 4; ++q4) ow[q4] = *(const v2u*)(zp + 16 * (4 * (wid & 1) + q4) + 4 * fq); }
        __syncthreads();
        {
            const float inter = sc[tq];
            const float den = inter * qn[tq] + sc[128 + tq];
            const float scl = __builtin_amdgcn_rcpf(fmaxf(fabsf(den), sc[64 + tq]));
            float ss = 0.f;
            bf16x8 qf[4], wf[2];
#pragma unroll
            for (int k4 = 0; k4 < 4; ++k4) qf[k4] = *(const LAS bf16x8*)(qs + tq * 136 + 32 * k4 + 8 * fq);
#pragma unroll
            for (int k2 = 0; k2 < 2; ++k2) wf[k2] = *(const LAS bf16x8*)(wsm + tq * 72 + 32 * k2 + 8 * fq);
            bf16x8 cf[4][4], vfr[4][2];
#pragma unroll
            for (int q4 = 0; q4 < 4; ++q4) { const int et = 4 * (wid & 1) + q4;
#pragma unroll
                for (int k4 = 0; k4 < 4; ++k4) cf[q4][k4] = *(const LAS bf16x8*)(CTr + (16 * et + fr) * 136 + 32 * k4 + 8 * fq);
#pragma unroll
                for (int k2 = 0; k2 < 2; ++k2) vfr[q4][k2] = *(const LAS bf16x8*)(vT + (16 * et + fr) * 72 + 32 * k2 + 8 * fq); }
            f32x4 acc4[4];
#pragma unroll
            for (int q4 = 0; q4 < 4; ++q4) acc4[q4] = (f32x4){0.f, 0.f, 0.f, 0.f};
            __builtin_amdgcn_s_setprio(1);
#pragma unroll
            for (int k4 = 0; k4 < 4; ++k4)
#pragma unroll
                for (int q4 = 0; q4 < 4; ++q4) acc4[q4] = MFMA16(cf[q4][k4], qf[k4], acc4[q4]);
            __builtin_amdgcn_s_setprio(0);
#pragma unroll
            for (int q4 = 0; q4 < 4; ++q4) acc4[q4] = acc4[q4] * inter;
#pragma unroll
            for (int k2 = 0; k2 < 2; ++k2)
#pragma unroll
                for (int q4 = 0; q4 < 4; ++q4) acc4[q4] = MFMA16(vfr[q4][k2], wf[k2], acc4[q4]);
#pragma unroll
            for (int q4 = 0; q4 < 4; ++q4) { hv[q4] = acc4[q4] * scl; ss += (hv[q4].x * hv[q4].x + hv[q4].y * hv[q4].y) + (hv[q4].z * hv[q4].z + hv[q4].w * hv[q4].w); }
            ss += __shfl_xor(ss, 16); ss += __shfl_xor(ss, 32);
            if (fq == 0) lds_addf(ssq + par * 64 + tq, ss);
        }
        {
            const float decay = sc[192];
            bf16x8 vf[2];
#pragma unroll
            for (int k2 = 0; k2 < 2; ++k2) vf[k2] = *(const LAS bf16x8*)(vT + (16 * wid + fr) * 72 + 32 * k2 + 8 * fq);
            bf16x8 kf[8][2];
#pragma unroll
            for (int dt = 0; dt < 8; ++dt)
#pragma unroll
                for (int k2 = 0; k2 < 2; ++k2) kf[dt][k2] = *(const LAS bf16x8*)(kT + (16 * dt + fr) * 72 + 32 * k2 + 8 * fq);
#pragma unroll
            for (int dt = 0; dt < 8; ++dt) Cacc[dt] = Cacc[dt] * decay;
            __builtin_amdgcn_s_setprio(1);
#pragma unroll
            for (int k2 = 0; k2 < 2; ++k2)
#pragma unroll
                for (int dt = 0; dt < 8; ++dt) Cacc[dt] = MFMA16(kf[dt][k2], vf[k2], Cacc[dt]);
            __builtin_amdgcn_s_setprio(0);
#pragma unroll
            for (int dt = 0; dt < 8; ++dt) { v2u cw; cw.x = pk2(Cacc[dt].x, Cacc[dt].y); cw.y = pk2(Cacc[dt].z, Cacc[dt].w);
                *(LAS v2u*)(CTw + (16 * wid + fr) * 136 + 16 * dt + 4 * fq) = cw; }
            { const int d = tid >> 2, qd = tid & 3; float s_ = 0.f;
#pragma unroll
                for (int j = 0; j < 2; ++j) { const v4u kk = *(const LAS v4u*)(kT + d * 72 + 16 * qd + 8 * j); s_ += (bflo(kk.x) + bfhi(kk.x)) + (bflo(kk.y) + bfhi(kk.y)) + (bflo(kk.z) + bfhi(kk.z)) + (bflo(kk.w) + bfhi(kk.w)); }
                s_ += __shfl_xor(s_, 1); s_ += __shfl_xor(s_, 2);
                if (qd == 0) nvec[d] = decay * nvec[d] + s_; }
        }
        __syncthreads();
    }
    MS_EMIT(31);
#undef MS_LOAD
#undef MS_EMIT
}
constexpr int RP_RX = 0, RP_US = 18240, RP_A = 35648, RP_B = 35648 + 33792, RP_CW = 35648 + 2 * 33792, RP_P = 132;
template <bool DRY> __device__ __forceinline__ void rg_pre(const Params& P, int l, int b, int n, int cgp, LAS unsigned char* lds, int tid) {
    asm volatile("" : "+v"(tid));
    const int lane = tid & 63, wid = __builtin_amdgcn_readfirstlane(tid >> 6), fr = lane & 15, fq = lane >> 4;
    LAS bf16* rawx = (LAS bf16*)(lds + RP_RX); LAS bf16* us = (LAS bf16*)(lds + RP_US); LAS float* a_s = (LAS float*)(lds + RP_A); LAS float* b_s = (LAS float*)(lds + RP_B); LAS float* cw = (LAS float*)(lds + RP_CW); LAS float* cb = cw + 512;
    bf16* z = (bf16*)(P.ws + WS_BIG); const bf16* zhalo = (const bf16*)(P.ws + WS_ZHALO); bf16* rga = (bf16*)(P.ws + WS_RGA); float* rgsum = (float*)(P.ws + WS_RGSUM);
    const int colx = n * 128; const size_t rowb = (size_t)b * SEQ;
    { const float* w = P.rg_conv_w + (size_t)l * 4 * 512; const int j = tid >> 7, d = tid & 127; cw[j * 128 + d] = w[j * 512 + n * 128 + d]; if (tid < 128) cb[tid] = P.rg_conv_b[l * 512 + n * 128 + tid]; }
    bf16x8 Wr[4], Wi[4];
    { const float* wa = P.rg_wa + ((size_t)l * 4 + n) * 16384; const float* wx = P.rg_wx + ((size_t)l * 4 + n) * 16384; const int j = 16 * wid + fr;
#pragma unroll
      for (int k4 = 0; k4 < 4; ++k4) {
          unsigned pr[4], pi[4];
#pragma unroll
          for (int x2 = 0; x2 < 4; ++x2) { const int i0 = 32 * k4 + 8 * fq + 2 * x2; pr[x2] = pk2(wa[i0 * 128 + j], wa[(i0 + 1) * 128 + j]); pi[x2] = pk2(wx[i0 * 128 + j], wx[(i0 + 1) * 128 + j]); }
          Wr[k4] = __builtin_bit_cast(bf16x8, (v4u){pr[0], pr[1], pr[2], pr[3]}); Wi[k4] = __builtin_bit_cast(bf16x8, (v4u){pi[0], pi[1], pi[2], pi[3]}); } }
    float ba[4], bx[4], lsl[4];
#pragma unroll
    for (int i = 0; i < 4; ++i) { const int cc = l * 512 + n * 128 + 16 * wid + 4 * fq + i; ba[i] = P.rg_ba[cc]; bx[i] = P.rg_bx[cc]; lsl[i] = 8.f * logsigmoidf_(P.rg_lambda[cc]); }
    const int r = tid >> 3, c16r = (tid & 7) * 16;
    v4u px0, px1, phx = (v4u){0u, 0u, 0u, 0u};
#define RP_LOAD(C) do { const bf16* zp = z + (rowb + (C) * 64 + r) * ZP + colx + c16r; px0 = *(const v4u*)zp; px1 = *(const v4u*)(zp + 8); phx = (v4u){0u, 0u, 0u, 0u}; \
        if (tid < 48 && (C) > 0) phx = *(const v4u*)(zhalo + ((size_t)(b * 32 + (C) - 1) * 3 + (tid >> 4)) * 1536 + n * 128 + (tid & 15) * 8); } while (0)
    RP_LOAD(cgp * 4);
    for (int ci = 0; ci < 4; ++ci) {
        const int c = cgp * 4 + ci, t0 = c * 64;
        *(LAS v4u*)(rawx + (r + 3) * 136 + c16r) = px0; *(LAS v4u*)(rawx + (r + 3) * 136 + c16r + 8) = px1;
        if (tid < 48) *(LAS v4u*)(rawx + (tid >> 4) * 136 + (tid & 15) * 8) = phx;
        if (ci + 1 < 4) RP_LOAD(c + 1);
        __syncthreads();
        { const int c16 = wid * 16; float au[16];
#pragma unroll
          for (int i = 0; i < 16; ++i) au[i] = cb[c16 + i];
#pragma unroll
          for (int j = 0; j < 4; ++j) { const v4u r0 = *(const LAS v4u*)(rawx + (lane + j) * 136 + c16), r1 = *(const LAS v4u*)(rawx + (lane + j) * 136 + c16 + 8);
              const unsigned xw[8] = {r0.x, r0.y, r0.z, r0.w, r1.x, r1.y, r1.z, r1.w};
#pragma unroll
              for (int i = 0; i < 8; ++i) { au[2 * i] += cw[j * 128 + c16 + 2 * i] * bflo(xw[i]); au[2 * i + 1] += cw[j * 128 + c16 + 2 * i + 1] * bfhi(xw[i]); } }
          v4u o;
          o.x = pk2(au[0], au[1]); o.y = pk2(au[2], au[3]); o.z = pk2(au[4], au[5]); o.w = pk2(au[6], au[7]); *(LAS v4u*)(us + lane * 136 + c16) = o;
          o.x = pk2(au[8], au[9]); o.y = pk2(au[10], au[11]); o.z = pk2(au[12], au[13]); o.w = pk2(au[14], au[15]); *(LAS v4u*)(us + lane * 136 + c16 + 8) = o; }
        __syncthreads();
#if PROBE_SEL == 24
        if (!DRY)
#endif
#pragma unroll
        for (int tt = 0; tt < 4; ++tt) {
            f32x4 ar = (f32x4){0.f, 0.f, 0.f, 0.f}, ai = (f32x4){0.f, 0.f, 0.f, 0.f};
#pragma unroll
            for (int k4 = 0; k4 < 4; ++k4) { const bf16x8 bb = *(const LAS bf16x8*)(us + (16 * tt + fr) * 136 + 32 * k4 + 8 * fq); ar = MFMA16(Wr[k4], bb, ar); ai = MFMA16(Wi[k4], bb, ai); }
            const int t = 16 * tt + fr, c0 = 16 * wid + 4 * fq;
            const v2u uw = *(const LAS v2u*)(us + t * 136 + c0);
            const float uu[4] = {bflo(uw.x), bfhi(uw.x), bflo(uw.y), bfhi(uw.y)};
            f32x4 av, bv;
#pragma unroll
            for (int i = 0; i < 4; ++i) { const float rr = sigmoidf_(ar[i] + ba[i]), ii = sigmoidf_(ai[i] + bx[i]); const float la = rr * lsl[i]; av[i] = __expf(la);
                const float x2 = 2.f * la; const float poly = -x2 * (1.f + x2 * (0.5f + x2 * (0.16666667f + x2 * (0.041666668f + x2 * 0.0083333338f))));
                const float om = (x2 < -0.25f) ? 1.f - __expf(x2) : poly;
                bv[i] = __builtin_amdgcn_sqrtf(fmaxf(om, 0.f)) * ii * uu[i]; }
            *(LAS f32x4*)(a_s + t * RP_P + c0) = av; *(LAS f32x4*)(b_s + t * RP_P + c0) = bv;
        }
        __syncthreads();
        { const int chn = tid & 127, qt = tid >> 7; LAS float* qsum = cw + 640;
          float hc = 0.f, ap = 1.f;
#pragma unroll
          for (int t = 0; t < 16; ++t) { const int tt_ = qt * 16 + t; const float a = a_s[tt_ * RP_P + chn]; hc = a * hc + b_s[tt_ * RP_P + chn]; ap *= a; b_s[tt_ * RP_P + chn] = hc; a_s[tt_ * RP_P + chn] = ap; }
          qsum[(qt * 128 + chn) * 2] = ap; qsum[(qt * 128 + chn) * 2 + 1] = hc;
          __syncthreads();
          float hin_ = 0.f, ain_ = 1.f;
#pragma unroll
          for (int q = 0; q < 3; ++q) if (q < qt) { const float aq = qsum[(q * 128 + chn) * 2], hq = qsum[(q * 128 + chn) * 2 + 1]; hin_ = aq * hin_ + hq; ain_ *= aq; }
          if (qt > 0) {
#pragma unroll
              for (int t = 0; t < 16; ++t) { const int tt_ = qt * 16 + t; const float al = a_s[tt_ * RP_P + chn]; b_s[tt_ * RP_P + chn] += al * hin_; a_s[tt_ * RP_P + chn] = al * ain_; } }
          if (qt == 3) { float* sp = rgsum + ((size_t)(b * 32 + c) * 512 + n * 128 + chn) * 2; sp[0] = ap * ain_; sp[1] = hc + ap * hin_; } }
        __syncthreads();
        { const size_t row = rowb + t0 + r; float hl[16], apv[16];
#pragma unroll
          for (int i = 0; i < 4; ++i) { const f32x4 x = *(const LAS f32x4*)(b_s + r * RP_P + c16r + 4 * i), y = *(const LAS f32x4*)(a_s + r * RP_P + c16r + 4 * i);
              hl[4 * i] = x.x; hl[4 * i + 1] = x.y; hl[4 * i + 2] = x.z; hl[4 * i + 3] = x.w; apv[4 * i] = y.x; apv[4 * i + 1] = y.y; apv[4 * i + 2] = y.z; apv[4 * i + 3] = y.w; }
          v4u o;
          o.x = pk2(hl[0], hl[1]); o.y = pk2(hl[2], hl[3]); o.z = pk2(hl[4], hl[5]); o.w = pk2(hl[6], hl[7]); if (!DRY) *(v4u*)(z + row * ZP + colx + c16r) = o;
          o.x = pk2(hl[8], hl[9]); o.y = pk2(hl[10], hl[11]); o.z = pk2(hl[12], hl[13]); o.w = pk2(hl[14], hl[15]); if (!DRY) *(v4u*)(z + row * ZP + colx + c16r + 8) = o;
          o.x = pk2(apv[0], apv[1]); o.y = pk2(apv[2], apv[3]); o.z = pk2(apv[4], apv[5]); o.w = pk2(apv[6], apv[7]); *(v4u*)(rga + row * 512 + colx + c16r) = o;
          o.x = pk2(apv[8], apv[9]); o.y = pk2(apv[10], apv[11]); o.z = pk2(apv[12], apv[13]); o.w = pk2(apv[14], apv[15]); *(v4u*)(rga + row * 512 + colx + c16r + 8) = o; }
        __syncthreads();
    }
}
__device__ __forceinline__ void rg_scan(const Params& P, int b, int n, int tid) {
    asm volatile("" : "+v"(tid));
    if (tid < 128) {
        const float* rgsum = (const float*)(P.ws + WS_RGSUM); float* hin = (float*)(P.ws + WS_RGHIN);
        const int ch = n * 128 + tid; float h = 0.f;
        typedef float f32x2v_ __attribute__((ext_vector_type(2)));
        f32x2v_ sv[32];
#pragma unroll
        for (int c = 0; c < 32; ++c) sv[c] = *(const f32x2v_*)(rgsum + ((size_t)(b * 32 + c) * 512 + ch) * 2);
#pragma unroll
        for (int c = 0; c < 32; ++c) { hin[(size_t)(b * 32 + c) * 512 + ch] = h; h = sv[c].x * h + sv[c].y; }
    }
}

__global__ void __launch_bounds__(NWAVES * 64, 2) fwd_megakernel(Params P) {
    extern __shared__ __attribute__((aligned(16))) unsigned char lds_raw[];
    cg::grid_group grid = cg::this_grid();
    LAS unsigned char* lds = (LAS unsigned char*)lds_raw;
    volatile LAS unsigned* MISC = (volatile LAS unsigned*)(lds + MISC_OFF);
    if (threadIdx.x < 64) MISC[threadIdx.x] = 0u;
    __syncthreads();
    (void)xcd_barrier_post((unsigned*)(P.ws + WS_CTL) + 1024, MISC + 8);
#define SEAM() do { XcdBarrier xb_; xb_.bar = (unsigned*)(P.ws + WS_CTL) + 1024; xb_.x = xb_xcc_id(); xb_.st = (volatile LAS unsigned*)(lds + MISC_OFF) + 8; xcd_barrier(xb_); } while (0)
    const int G = gridDim.x, NGW = G * NWAVES;
#define FRESH() int tid = threadIdx.x; asm volatile("" : "+v"(tid)); const int lane = tid & 63, wave = __builtin_amdgcn_readfirstlane(tid >> 6), gw = blockIdx.x * NWAVES + wave; (void)lane; (void)gw
    unsigned char* ws = P.ws;
    unsigned* ctl = (unsigned*)(ws + WS_CTL);
    float* rstd = (float*)(ws + WS_RSTD); float* rgss = (float*)(ws + WS_RGSS); float* ssa = (float*)(ws + WS_SSA); (void)rstd; float* gates = (float*)(ws + WS_GATES); float* rope = (float*)(ws + WS_ROPE);
    bf16* xb = (bf16*)(ws + WS_XB); bf16* zb = (bf16*)(ws + WS_BIG);

#pragma unroll 1
    for (int l = 0; l < DEPTH; ++l) {
        const float* xin = (l == 0) ? P.x : P.out;
        if (l == 0) {
          { FRESH();
            convert_weights<0>(P, l, lds, gw, NGW, wave, lane);
            for (int i0 = 0; i0 < M * 8; i0 += G * 512) { const int i = i0 + blockIdx.x * 512 + tid; if (i >= M * 8) break; const int row = i >> 3, j = i & 7;
                const float inv = powf(500000.f, -(float)j * 0.125f); const float ang = (float)P.pos[row] * inv; float sn, cs; sincosf(ang, &sn, &cs);
                rope[(size_t)row * 16 + j] = cs; rope[(size_t)row * 16 + 8 + j] = sn; }
            rowpass<false>(xin, xb, ssa, nullptr, nullptr, gw, NGW, lane); }
          grid.sync();
        }
        { pg8::Gemm g{xb, (const bf16*)(ws + WS_WIN), M, ZP + 256, DM, DM}; pg8::StaticOrder S; S.init(M, ZP + 256, G, (int)blockIdx.x);
          pg8::EpiZ E{zb, ssa, rope, (bf16*)(ws + WS_ZHALO), gates};
#ifndef NO_G1
          pg8::gemm_phase<pg8::EpiZ, pg8::StaticOrder, true, true>(lds, g, S, E);
#if PROBE_SEL == 1
          pg8::gemm_phase<pg8::EpiZ, pg8::StaticOrder, true, true>(lds, g, S, E);
#endif
#endif
        }
        SEAM();
        {
            FRESH();
            for (int i0 = 0; i0 < M; i0 += G * 512) { const int i = i0 + blockIdx.x * 512 + tid; if (i < M) { rgss[i] = 0.f; ssa[i] = 0.f; } }
            for (int bh = (int)blockIdx.x; bh < 32; bh += G) ml_chain(P, l, bh >> 2, bh & 3, lds, tid);
            unsigned* cpre = ctl + l * 128 + 32;
#if PROBE_SEL == 21 || PROBE_SEL == 22 || PROBE_SEL == 23 || PROBE_SEL == 24 || PROBE_SEL == 25
            { unsigned* c2 = ctl + l * 128 + 100;
              for (;;) {
                if (tid == 0) MISC[0] = atomicAdd(c2, 1u);
                __syncthreads(); const unsigned u = MISC[0]; __syncthreads();
                if (u >= 1280u) break;
#if PROBE_SEL != 23
                if (u < 256u) rg_pre<true>(P, l, (int)(u >> 5), (int)((u >> 3) & 3), (int)(u & 7), lds, tid);
#endif
#if PROBE_SEL != 22 && PROBE_SEL != 24 && PROBE_SEL != 25
                if (u >= 256u) { const unsigned v = u - 256u; ml_pre<true>(P, l, (int)(v >> 7), (int)((v >> 5) & 3), (int)(v & 31), lds, tid); }
#endif
              }
              SEAM(); }
#endif
            for (;;) {
                if (tid == 0) MISC[0] = atomicAdd(cpre, 1u);
                __syncthreads(); const unsigned u = MISC[0]; __syncthreads();
                if (u >= 1280u) break;
                if (u < 256u) rg_pre<false>(P, l, (int)(u >> 5), (int)((u >> 3) & 3), (int)(u & 7), lds, tid);
                else { const unsigned v = u - 256u; ml_pre<false>(P, l, (int)(v >> 7), (int)((v >> 5) & 3), (int)(v & 31), lds, tid); }
            }
        }
        SEAM();
        {
            FRESH();
            unsigned* cseq = ctl + l * 128, *catt = ctl + l * 128 + 64;
#if PROBE_SEL == 20
            { unsigned* c2 = ctl + l * 128 + 96;
              for (;;) {
                if (tid == 0) MISC[0] = atomicAdd(c2, 1u);
                __syncthreads(); const unsigned u = MISC[0]; __syncthreads();
                if (u >= 32u) break;
                ml_seq<true>(P, l, (int)(u >> 2), (int)(u & 3), lds, tid); __syncthreads();
              }
              SEAM(); }
#endif
            for (;;) {
                if (tid == 0) MISC[0] = atomicAdd(cseq, 1u);
                __syncthreads(); const unsigned u = MISC[0]; __syncthreads();
                if (u >= 64u) break;
                if (u < 32u) ml_seq<false>(P, l, (int)(u >> 2), (int)(u & 3), lds, tid); else rg_scan(P, (int)((u - 32) >> 2), (int)((u - 32) & 3), tid);
                __syncthreads();
            }
            for (;;) {
                if (tid == 0) MISC[0] = atomicAdd(catt, 1u);
                __syncthreads(); const unsigned u = MISC[0]; __syncthreads();
                if (u >= 1024u) break;
                const int qb = 7 - (int)(u >> 7), rem = (int)(u & 127), b = rem >> 4, vh = rem & 15, hc = vh >> 1, e = vh & 1, hh = vh >> 2;
                attn_body::attn_unit<8>(b, qb, (const attn_body::bf16*)(zb + 1024 + hc * 64), (const attn_body::bf16*)(zb + 2048 + hc * 64), (const attn_body::bf16*)(zb + 2560 + hh * 128 + e * 64),
                                        (attn_body::bf16*)(xb + vh * 64), (char*)lds_raw);
            }
            { unsigned* ccv = ctl + l * 128 + 48;
              for (;;) {
                if (tid == 0) MISC[0] = atomicAdd(ccv, 1u);
                __syncthreads(); const unsigned u = MISC[0]; __syncthreads();
                if (u >= 624u) break;
                convert_weights<1>(P, l, lds, (int)u * NWAVES + wave, 1 << 30, wave, lane);
                __syncthreads();
              } }
        }
        SEAM();
        { FRESH(); finalize_mixers(P, l, gw, NGW, lane); }
        SEAM();
#if PROBE_SEL == 5
        for (int i = 0; i < 10; ++i) SEAM();
#endif
        { pg8::Gemm g{zb + 512, (const bf16*)(ws + WS_WOUT), M, DM, DMIX, ZP}; pg8::StaticOrder S; S.init(M, DM, G, (int)blockIdx.x);
          pg8::EpiResN E{xin, P.out, xb, rgss};
          pg8::gemm_phase<pg8::EpiResN, pg8::StaticOrder, true, true>(lds, g, S, E); }
        SEAM();
        { pg8::Gemm g{xb, (const bf16*)(ws + WS_WUP), M, UP, DM, DM}; pg8::StaticOrder S; S.init(M, UP, G, (int)blockIdx.x);
          pg8::EpiUG E{zb, rgss, (bf16*)(ws + WS_HALO), (bf16*)(ws + WS_UHEAD), P.ffn_conv_w + (size_t)l * 3 * UP, P.ffn_conv_b + (size_t)l * UP};
#ifndef NO_G4
          pg8::gemm_phase<pg8::EpiUG, pg8::StaticOrder, true, true>(lds, g, S, E);
#if PROBE_SEL == 2
          pg8::gemm_phase<pg8::EpiUG, pg8::StaticOrder, true, true>(lds, g, S, E);
#endif
#endif
          if (l + 1 < DEPTH) { FRESH();
              if (G == 256) { if (blockIdx.x >= 128) convert_weights<0>(P, l + 1, lds, ((int)blockIdx.x - 128) * NWAVES + wave, 128 * NWAVES, wave, lane); }
              else convert_weights<0>(P, l + 1, lds, gw, NGW, wave, lane); }
        }
        SEAM();
#ifndef NO_CG
        { FRESH(); conv_gate(P, l, tid, (int)blockIdx.x, 256, G); }
#endif
        SEAM();
        { pg8::Gemm g{zb, (const bf16*)(ws + WS_WDN), M, DM, DFF, DFF}; pg8::StaticOrder S; S.init(M, DM, G, (int)blockIdx.x);
          if (l + 1 < DEPTH) { pg8::EpiResN E{P.out, P.out, xb, ssa};
              pg8::gemm_phase<pg8::EpiResN, pg8::StaticOrder, true, true>(lds, g, S, E); }
          else { pg8::EpiResL E{P.out, P.out, xb, ssa};
              pg8::gemm_phase<pg8::EpiResL, pg8::StaticOrder, true, true>(lds, g, S, E); }
        }
        SEAM();
    }
    { FRESH(); final_norm(P, gw, NGW, lane, P.out); }
}

extern "C" void kernel_launch(void* const* d_in, const int* in_sizes, int n_in, void* d_out, int out_size, void* d_ws, size_t ws_size, hipStream_t stream) {
    static int grid_blocks = 0;
    if (grid_blocks == 0) {
        if (n_in != 26 || out_size != M * DM || ws_size < WS_END) { fprintf(stderr, "kernel_launch: unexpected shapes (n_in %d out %d ws %zu)\n", n_in, out_size, ws_size); grid_blocks = -1; return; }
        int dev = 0, cus = 0, per_cu = 0;
        hipGetDevice(&dev); hipDeviceGetAttribute(&cus, hipDeviceAttributeMultiprocessorCount, dev);
        if (hipFuncSetAttribute((const void*)fwd_megakernel, hipFuncAttributeMaxDynamicSharedMemorySize, LDS_BYTES) != hipSuccess) { fprintf(stderr, "kernel_launch: hipFuncSetAttribute failed\n"); grid_blocks = -1; return; }
        if (hipOccupancyMaxActiveBlocksPerMultiprocessor(&per_cu, (const void*)fwd_megakernel, NWAVES * 64, LDS_BYTES) != hipSuccess || per_cu < 1) { fprintf(stderr, "kernel_launch: occupancy query says %d\n", per_cu); per_cu = 1; (void)hipGetLastError(); }
        grid_blocks = cus * 1;
    }
    if (grid_blocks < 0) return;
    hipMemsetAsync((char*)d_ws + WS_CTL, 0, 32768, stream);
    Params p{};
    const void** pp = (const void**)&p;
    for (int i = 0; i < 26; ++i) pp[i] = d_in[i];
    p.out = (float*)d_out; p.ws = (unsigned char*)d_ws;
    void* args[] = {&p};
    hipError_t e = hipLaunchCooperativeKernel((const void*)fwd_megakernel, dim3(grid_blocks), dim3(NWAVES * 64), args, LDS_BYTES, stream);
    if (e != hipSuccess) fprintf(stderr, "cooperative launch failed: %s (grid %d)\n", hipGetErrorString(e), grid_blocks);
}
```

```cpp
#include <hip/hip_runtime.h>
#include <hip/hip_cooperative_groups.h>
#include <hip/hip_bf16.h>
#include <cstdio>
#include <cstdint>
#include <cmath>
namespace pg8 {
#define PG8_LAS __attribute__((address_space(3)))
typedef unsigned short bf16_t;
typedef short bf16x8 __attribute__((ext_vector_type(8)));
typedef float f32x4 __attribute__((ext_vector_type(4)));
typedef unsigned u32x4 __attribute__((ext_vector_type(4)));
constexpr int BM = 256, BK = 64, HALF = 128, HTB = HALF * BK * 2  , STAGE_BYTES = 8 * HTB, NXCD = 8, WGM = 8;

__host__ __device__ __forceinline__ int lds_byte(int r, int c) { const int st = (r >> 4) * 2 + (c >> 5), rr = r & 15, cc = c & 31, ob = rr * 64 + cc * 2; return st * 1024 + (ob ^ (((ob >> 9) & 1) << 5)); }
__host__ __device__ __forceinline__ void stage_rc(int b, int& R, int& C) { const int st = b / 1024, sb = b % 1024, swz = sb ^ (((sb >> 9) & 1) << 5); R = (st >> 1) * 16 + swz / 64; C = (st & 1) * 32 + (swz % 64) / 2; }
__host__ __device__ __forceinline__ int perm32(int rho) { const int n = rho >> 4, i = rho & 15; return 8 * (i >> 2) + 4 * n + (i & 3); }

struct Unit { int pm, pn; };
struct Gemm { const bf16_t* A; const bf16_t* Bt; int M, N, K, lda; };

struct StaticOrder {
    int nM, nN, nwg, G, c;
    __host__ __device__ void init(int M, int N, int G_, int c_) { nM = M / BM; nN = N / BM; nwg = nM * nN; G = G_; c = c_; }
    __host__ __device__ bool next(int i, Unit& u) const {
        const long L = (long)i * G + c; if (L >= nwg) return false;
        int wgid = (int)L; { const int q = nwg / NXCD, r = nwg % NXCD, xcd = wgid % NXCD, off = wgid / NXCD; wgid = (xcd < r ? xcd * (q + 1) : r * (q + 1) + (xcd - r) * q) + off; }
        const int nig = WGM * nN, gid = wgid / nig, fm = gid * WGM, gsz = (nM - fm) < WGM ? (nM - fm) : WGM;
        u.pm = fm + ((wgid % nig) % gsz); u.pn = (wgid % nig) / gsz; return true;
    }
    __device__ __forceinline__ void a_ready(const Unit&) const {}
    __device__ __forceinline__ void done(const Unit&) const {}
};

__device__ __forceinline__ unsigned cvt_pk_bf16(float lo, float hi) { unsigned r; asm volatile("v_cvt_pk_bf16_f32 %0, %1, %2" : "=v"(r) : "v"(lo), "v"(hi)); return r; }
typedef float f32x2 __attribute__((ext_vector_type(2)));

constexpr float QSCALE = 0.125f * 1.4426950408889634f;
constexpr int ZP = 4608, UP = 5632;
__device__ __forceinline__ u32x4 pack8(const f32x4 v0, const f32x4 v1) { u32x4 w; w.x = cvt_pk_bf16(v0[0], v0[1]); w.y = cvt_pk_bf16(v0[2], v0[3]); w.z = cvt_pk_bf16(v1[0], v1[1]); w.w = cvt_pk_bf16(v1[2], v1[3]); return w; }
struct EpiZ {
    static constexpr bool PERM = true, AFTER_DRAIN = false;
    bf16_t* Z; const float* rstd; const float* rope; bf16_t* zhalo; float* gates;
    __device__ __forceinline__ void operator()(const f32x4 (&acc)[2][2][4][2], const Unit& u, int wr, int wc, int fr, int fq) const {
        const int row0 = u.pm * BM + wr * 64 + fr, col0 = u.pn * BM + wc * 32 + 8 * fq;
        const bool isq = (u.pn == 4 || u.pn == 5), isk = (u.pn == 8 || u.pn == 9);
        const bool dorope = (isq || isk) && ((wc & 1) == 0);
        const float sc = isq ? QSCALE : 1.f;
        const int hblk = (u.pn < 2) ? 0 : (u.pn == 12 || u.pn == 13) ? 1 : (u.pn == 14 || u.pn == 15) ? 2 : -1;
        float rsv[2][4];
#pragma unroll
        for (int ai = 0; ai < 2; ++ai)
#pragma unroll
            for (int m = 0; m < 4; ++m) rsv[ai][m] = rstd[row0 + ai * HALF + m * 16];
        f32x4 rpn[4];
        if (dorope) { const f32x4* rp = (const f32x4*)(rope + (size_t)row0 * 16);
#pragma unroll
            for (int q = 0; q < 4; ++q) rpn[q] = rp[q]; }
#pragma unroll
        for (int ai = 0; ai < 2; ++ai) {
#pragma unroll
            for (int m = 0; m < 4; ++m) {
                const int row = row0 + ai * HALF + m * 16;
                f32x4 rpc[4];
                if (dorope) {
#pragma unroll
                    for (int q = 0; q < 4; ++q) rpc[q] = rpn[q];
                    if (ai * 4 + m < 7) { const int nrow = row0 + ((ai * 4 + m + 1) >> 2) * HALF + ((ai * 4 + m + 1) & 3) * 16; const f32x4* rp = (const f32x4*)(rope + (size_t)nrow * 16);
#pragma unroll
                        for (int q = 0; q < 4; ++q) rpn[q] = rp[q]; }
                }
                const float rs = sc * __builtin_amdgcn_rsqf(rsv[ai][m] * (1.f / 1024.f) + 1e-6f);
                f32x4 v[2][2];
#pragma unroll
                for (int bj = 0; bj < 2; ++bj)
#pragma unroll
                    for (int n = 0; n < 2; ++n) v[bj][n] = acc[ai][bj][m][n] * rs;
                if (dorope) {
                    const f32x4 c0 = rpc[0], c1 = rpc[1], s0 = rpc[2], s1 = rpc[3];
#pragma unroll
                    for (int bj = 0; bj < 2; ++bj) {
                        f32x4 p0, p1;
#pragma unroll
                        for (int i = 0; i < 4; ++i) { p0[i] = __shfl_xor(v[bj][0][i], 16); p1[i] = __shfl_xor(v[bj][1][i], 16); }
                        if (fq == 0) { v[bj][0] = v[bj][0] * c0 - p0 * s0; v[bj][1] = v[bj][1] * c1 - p1 * s1; }
                        else if (fq == 1) { v[bj][0] = v[bj][0] * c0 + p0 * s0; v[bj][1] = v[bj][1] * c1 + p1 * s1; }
                    }
                }
                if (u.pn == 18) { if (wc == 0 && fq == 0) { *(f32x4*)(gates + (size_t)row * 8) = v[0][0]; *(f32x4*)(gates + (size_t)row * 8 + 4) = v[0][1]; } continue; }
                bf16_t* rowp = Z + (size_t)row * ZP + col0;
#pragma unroll
                for (int bj = 0; bj < 2; ++bj) { const u32x4 w = pack8(v[bj][0], v[bj][1]); *(u32x4*)(rowp + bj * HALF) = w;
                    if (hblk >= 0 && m == 3 && fr >= 13) *(u32x4*)(zhalo + ((size_t)(row >> 6) * 3 + (fr - 13)) * 1536 + hblk * 512 + (u.pn & 1) * 256 + wc * 32 + 8 * fq + bj * HALF) = w; }
            }
        }
    }
};
struct EpiU {
    static constexpr bool PERM = true, AFTER_DRAIN = false;
    bf16_t* U; const float* rstd; bf16_t* halo;
    __device__ __forceinline__ void operator()(const f32x4 (&acc)[2][2][4][2], const Unit& u, int wr, int wc, int fr, int fq) const {
        const int row0 = u.pm * BM + wr * 64 + fr, col0 = u.pn * BM + wc * 32 + 8 * fq;
#pragma unroll
        for (int ai = 0; ai < 2; ++ai)
#pragma unroll
            for (int m = 0; m < 4; ++m) {
                const int row = row0 + ai * HALF + m * 16;
                const float rs = rstd[row];
                bf16_t* rowp = U + (size_t)row * UP + col0;
#pragma unroll
                for (int bj = 0; bj < 2; ++bj) {
                    const u32x4 w = pack8(acc[ai][bj][m][0] * rs, acc[ai][bj][m][1] * rs);
                    *(u32x4*)(rowp + bj * HALF) = w;
                    if (m == 3 && fr >= 14) *(u32x4*)(halo + ((size_t)(row >> 6) * 2 + (fr - 14)) * UP + col0 + bj * HALF) = w;
                }
            }
    }
};
struct EpiRes {
    static constexpr bool PERM = false, AFTER_DRAIN = false;
    const float* base; float* out;
    __device__ __forceinline__ void operator()(const f32x4 (&acc)[2][2][4][2], const Unit& u, int wr, int wc, int fr, int fq) const {
        const int col0 = u.pn * BM + wc * 32 + 4 * fq;
#pragma unroll
        for (int ai = 0; ai < 2; ++ai)
#pragma unroll
            for (int m = 0; m < 4; ++m) {
                const size_t off = (size_t)(u.pm * BM + ai * HALF + wr * 64 + m * 16 + fr) * 1024 + col0;
#pragma unroll
                for (int bj = 0; bj < 2; ++bj)
#pragma unroll
                    for (int n = 0; n < 2; ++n) { const f32x4 bs = *(const f32x4*)(base + off + bj * HALF + n * 16); *(f32x4*)(out + off + bj * HALF + n * 16) = bs + acc[ai][bj][m][n]; }
            }
    }
};

template <int CTRL> __device__ __forceinline__ float dppf_(float v) { return __int_as_float(__builtin_amdgcn_update_dpp(0, __float_as_int(v), CTRL, 0xf, 0xf, true)); }
#define DPPF(v, CTRL) dppf_<CTRL>(v)
struct EpiUG {
    static constexpr bool PERM = true, AFTER_DRAIN = false;
    bf16_t* H; const float* rstd; bf16_t* halo; bf16_t* uhead; const float* cw; const float* cb;
    __device__ __forceinline__ void operator()(const f32x4 (&acc)[2][2][4][2], const Unit& u, int wr, int wc, int fr, int fq) const {
        constexpr int DFF_ = 2816;
        const int ch0 = u.pn * 128 + wc * 32 + 8 * fq;
#pragma unroll
        for (int n = 0; n < 2; ++n) {
            const int ch = ch0 + 4 * n;
            const f32x4 wg0 = *(const f32x4*)(cw + ch), wg1 = *(const f32x4*)(cw + UP + ch), wg2 = *(const f32x4*)(cw + 2 * UP + ch), bg = *(const f32x4*)(cb + ch);
            const f32x4 wv0 = *(const f32x4*)(cw + DFF_ + ch), wv1 = *(const f32x4*)(cw + UP + DFF_ + ch), wv2 = *(const f32x4*)(cw + 2 * UP + DFF_ + ch), bv = *(const f32x4*)(cb + DFF_ + ch);
#pragma unroll
            for (int ai = 0; ai < 2; ++ai) {
                f32x4 pg = (f32x4){0.f, 0.f, 0.f, 0.f}, pv = pg;
                float rs4[4];
#pragma unroll
                for (int m = 0; m < 4; ++m) rs4[m] = rstd[u.pm * BM + ai * HALF + wr * 64 + m * 16 + fr];
#pragma unroll
                for (int m = 0; m < 4; ++m) {
                    const int row = u.pm * BM + ai * HALF + wr * 64 + m * 16 + fr;
                    const float rs = __builtin_amdgcn_rsqf(rs4[m] * (1.f / 1024.f) + 1e-6f);
                    const f32x4 g = acc[ai][0][m][n] * rs, v = acc[ai][1][m][n] * rs;
                    f32x4 g1, g2, v1, v2;
#pragma unroll
                    for (int i = 0; i < 4; ++i) {
                        g1[i] = DPPF(g[i], 0x111) + DPPF(pg[i], 0x10F); g2[i] = DPPF(g[i], 0x112) + DPPF(pg[i], 0x10E);
                        v1[i] = DPPF(v[i], 0x111) + DPPF(pv[i], 0x10F); v2[i] = DPPF(v[i], 0x112) + DPPF(pv[i], 0x10E);
                    }
                    const f32x4 cg = wg0 * g2 + wg1 * g1 + wg2 * g + bg, cv = wv0 * v2 + wv1 * v1 + wv2 * v + bv;
                    float hd[4];
#pragma unroll
                    for (int i = 0; i < 4; ++i) hd[i] = cg[i] * __builtin_amdgcn_rcpf(1.f + __expf(-cg[i])) * cv[i];
                    typedef unsigned u32x2_ __attribute__((ext_vector_type(2)));
                    u32x2_ w; w.x = cvt_pk_bf16(hd[0], hd[1]); w.y = cvt_pk_bf16(hd[2], hd[3]);
                    *(u32x2_*)(H + (size_t)row * DFF_ + ch) = w;
                    if ((m == 3 && fr >= 14) || (m == 0 && fr < 2)) {
                        u32x2_ rg, rv; rg.x = cvt_pk_bf16(g[0], g[1]); rg.y = cvt_pk_bf16(g[2], g[3]); rv.x = cvt_pk_bf16(v[0], v[1]); rv.y = cvt_pk_bf16(v[2], v[3]);
                        bf16_t* dst = (m == 3) ? halo + ((size_t)(row >> 6) * 2 + (fr - 14)) * UP : uhead + ((size_t)(row >> 6) * 2 + fr) * UP;
                        *(u32x2_*)(dst + ch) = rg; *(u32x2_*)(dst + DFF_ + ch) = rv;
                    }
                    pg = g; pv = v;
                }
            }
        }
    }
};

template <bool LAST> struct EpiResN_ {
    static constexpr bool PERM = false, AFTER_DRAIN = false;
    const float* base; float* out; bf16_t* xb; float* ssq;
    __device__ __forceinline__ void operator()(const f32x4 (&acc)[2][2][4][2], const Unit& u, int wr, int wc, int fr, int fq) const {
        typedef unsigned u32x2_ __attribute__((ext_vector_type(2)));
        const int col0 = u.pn * BM + wc * 32 + 4 * fq;
#pragma unroll
        for (int ai = 0; ai < 2; ++ai) {
            f32x4 pre[4][2][2];
#pragma unroll
            for (int m = 0; m < 4; ++m) { const size_t off = (size_t)(u.pm * BM + ai * HALF + wr * 64 + m * 16 + fr) * 1024 + col0;
#pragma unroll
                for (int bj = 0; bj < 2; ++bj)
#pragma unroll
                    for (int n = 0; n < 2; ++n) pre[m][bj][n] = *(const f32x4*)(base + off + bj * HALF + n * 16); }
            asm volatile("" ::: "memory");
#pragma unroll
            for (int m = 0; m < 4; ++m) {
                const int row = u.pm * BM + ai * HALF + wr * 64 + m * 16 + fr;
                const size_t off = (size_t)row * 1024 + col0; float ss = 0.f;
#pragma unroll
                for (int bj = 0; bj < 2; ++bj)
#pragma unroll
                    for (int n = 0; n < 2; ++n) { const f32x4 v = pre[m][bj][n] + acc[ai][bj][m][n]; *(f32x4*)(out + off + bj * HALF + n * 16) = v;
                        if (!LAST) { u32x2_ w; w.x = cvt_pk_bf16(v[0], v[1]); w.y = cvt_pk_bf16(v[2], v[3]); *(u32x2_*)(xb + off + bj * HALF + n * 16) = w;
                            ss += (v[0] * v[0] + v[1] * v[1]) + (v[2] * v[2] + v[3] * v[3]); } }
                if (!LAST) { ss += __shfl_xor(ss, 16); ss += __shfl_xor(ss, 32);
                    if (fq == 0) __hip_atomic_fetch_add(ssq + row, ss, __ATOMIC_RELAXED, __HIP_MEMORY_SCOPE_AGENT); }
            }
        }
    }
};
typedef EpiResN_<false> EpiResN;
typedef EpiResN_<true> EpiResL;

struct EpiResFinal {
    static constexpr bool PERM = false, AFTER_DRAIN = true;
    const float* base; float* out; float* ssq; unsigned* cnt; const float* gain;
    __device__ __forceinline__ void fused(f32x4 (&acc)[2][2][4][2], const Unit& u, int wr, int wc, int fr, int fq, PG8_LAS unsigned char* lds, int wid, int lane) const {
        const int col0 = u.pn * BM + wc * 32 + 4 * fq;
#pragma unroll
        for (int ai = 0; ai < 2; ++ai)
#pragma unroll
            for (int m = 0; m < 4; ++m) {
                const int row = u.pm * BM + ai * HALF + wr * 64 + m * 16 + fr;
                const size_t off = (size_t)row * 1024 + col0; float ss = 0.f;
#pragma unroll
                for (int bj = 0; bj < 2; ++bj)
#pragma unroll
                    for (int n = 0; n < 2; ++n) { const f32x4 v = *(const f32x4*)(base + off + bj * HALF + n * 16) + acc[ai][bj][m][n]; acc[ai][bj][m][n] = v;
                        ss += (v[0] * v[0] + v[1] * v[1]) + (v[2] * v[2] + v[3] * v[3]); }
                ss += __shfl_xor(ss, 16); ss += __shfl_xor(ss, 32);
                if (fq == 0) __hip_atomic_fetch_add(ssq + row, ss, __ATOMIC_RELAXED, __HIP_MEMORY_SCOPE_AGENT);
            }
        asm volatile("s_waitcnt vmcnt(0)" ::: "memory");
        __builtin_amdgcn_fence(__ATOMIC_RELEASE, "agent");
        if (lane == 0) __hip_atomic_fetch_add(cnt + 64 * u.pm, 1u, __ATOMIC_RELAXED, __HIP_MEMORY_SCOPE_AGENT);
        if (wid == 0) { unsigned sp = 0;
            while (__hip_atomic_load(cnt + 64 * u.pm, __ATOMIC_RELAXED, __HIP_MEMORY_SCOPE_AGENT) < 32u && ++sp < (1u << 22)) __builtin_amdgcn_s_sleep(2); }
        asm volatile("s_waitcnt vmcnt(0) lgkmcnt(0)" ::: "memory"); __builtin_amdgcn_s_barrier(); asm volatile("" ::: "memory");
        __builtin_amdgcn_fence(__ATOMIC_ACQUIRE, "agent");
        f32x4 gv[2][2];
#pragma unroll
        for (int bj = 0; bj < 2; ++bj)
#pragma unroll
            for (int n = 0; n < 2; ++n) gv[bj][n] = *(const f32x4*)(gain + col0 + bj * HALF + n * 16);
#pragma unroll
        for (int ai = 0; ai < 2; ++ai)
#pragma unroll
            for (int m = 0; m < 4; ++m) {
                const int row = u.pm * BM + ai * HALF + wr * 64 + m * 16 + fr;
                const size_t off = (size_t)row * 1024 + col0;
                const float r = __builtin_amdgcn_rsqf(__hip_atomic_load(ssq + row, __ATOMIC_RELAXED, __HIP_MEMORY_SCOPE_AGENT) * (1.f / 1024.f) + 1e-6f);
#pragma unroll
                for (int bj = 0; bj < 2; ++bj)
#pragma unroll
                    for (int n = 0; n < 2; ++n) *(f32x4*)(out + off + bj * HALF + n * 16) = acc[ai][bj][m][n] * r * gv[bj][n];
            }
    }
};
template <class Epi, class Sched, bool ALIGN_EPI = false, bool SP2 = false>
__device__ __forceinline__ void gemm_phase(PG8_LAS unsigned char* lds, const Gemm g, const Sched& S, const Epi& E) {
    int tid = threadIdx.x; asm volatile("" : "+v"(tid)); const int wid = __builtin_amdgcn_readfirstlane(tid >> 6), lane = tid & 63, wr = wid >> 2, wc = wid & 3, fr = lane & 15, fq = lane >> 4;
    const int K = g.K, nt = K / BK;
    unsigned voffA[2], voffB[2];
#pragma unroll
    for (int i = 0; i < 2; ++i) { int R, C; stage_rc(tid * 16 + i * 8192, R, C); const int Rb = Epi::PERM ? ((R & ~31) + perm32(R & 31)) : R;
        voffA[i] = (unsigned)(R * g.lda + C) * 2u; voffB[i] = (unsigned)(Rb * K + C) * 2u; }
    const size_t kstep = (size_t)(BK * 2);
    const size_t hstepB = (size_t)HALF * K * 2, hstepA = (size_t)HALF * g.lda * 2;
    const size_t tstepA = 2 * hstepA, tstepB = 2 * hstepB;
    const unsigned ldsw = (unsigned)wid * 1024u;
    const int aoff = lds_byte(wr * 64 + fr, fq * 8), boff = lds_byte(wc * 32 + fr, fq * 8);
#define PG8_SA(b, h) (((b) * 2 + (h)) * HTB)
#define PG8_SB(b, h) ((4 + (b) * 2 + (h)) * HTB)
#define PG8_STAGE(bufoff, gbase, voff) do { _Pragma("unroll") for (int _i = 0; _i < 2; ++_i) \
        __builtin_amdgcn_global_load_lds((const unsigned*)((const char*)(gbase) + (voff)[_i]), (PG8_LAS unsigned*)(lds + (bufoff) + ldsw + _i * 8192), 16, 0, 0); } while (0)
#define PG8_LDA(dst, b, h) do { _Pragma("unroll") for (int m = 0; m < 4; ++m) _Pragma("unroll") for (int k = 0; k < 2; ++k) dst[m][k] = *(const PG8_LAS bf16x8*)(lds + PG8_SA(b, h) + aoff + m * 2048 + k * 1024); } while (0)
#define PG8_LDB(dst, b, h) do { _Pragma("unroll") for (int n = 0; n < 2; ++n) _Pragma("unroll") for (int k = 0; k < 2; ++k) dst[n][k] = *(const PG8_LAS bf16x8*)(lds + PG8_SB(b, h) + boff + n * 2048 + k * 1024); } while (0)
#define PG8_MMA(ai, bj, At, Bt) do { __builtin_amdgcn_s_setprio(1); _Pragma("unroll") for (int m = 0; m < 4; ++m) _Pragma("unroll") for (int n = 0; n < 2; ++n) _Pragma("unroll") for (int k = 0; k < 2; ++k) \
        acc[ai][bj][m][n] = __builtin_amdgcn_mfma_f32_16x16x32_bf16(Bt[n][k], At[m][k], acc[ai][bj][m][n], 0, 0, 0); __builtin_amdgcn_s_setprio(0); } while (0)
#define PG8_WAIT_V(n) asm volatile("s_waitcnt vmcnt(" #n ")" ::: "memory")
#define PG8_WAIT_L(n) asm volatile("s_waitcnt lgkmcnt(" #n ")" ::: "memory")
#define PG8_BAR __builtin_amdgcn_s_barrier()
#define PG8_SCHED __builtin_amdgcn_sched_barrier(0)
    Unit cur, nxt; int ui = 0;
    if (!S.next(0, cur)) return;
    f32x4 acc[2][2][4][2];
#pragma unroll
    for (int a = 0; a < 2; ++a)
#pragma unroll
        for (int b = 0; b < 2; ++b)
#pragma unroll
            for (int m = 0; m < 4; ++m)
#pragma unroll
                for (int n = 0; n < 2; ++n) acc[a][b][m][n] = (f32x4){0.f, 0.f, 0.f, 0.f};
    bf16x8 At[4][2], B0[2][2], B1[2][2];
    const char* cA = (const char*)g.A + (size_t)cur.pm * tstepA; const char* cB = (const char*)g.Bt + (size_t)cur.pn * tstepB;
    S.a_ready(cur);
    if constexpr (SP2) {
        PG8_STAGE(PG8_SB(0, 0), cB, voffB); PG8_STAGE(PG8_SB(0, 1), cB + hstepB, voffB); PG8_STAGE(PG8_SA(0, 0), cA, voffA); PG8_STAGE(PG8_SA(0, 1), cA + hstepA, voffA);
        if (wr == 1) PG8_BAR;
        PG8_WAIT_V(2); PG8_BAR;
        PG8_STAGE(PG8_SB(1, 0), cB + kstep, voffB); PG8_STAGE(PG8_SA(1, 0), cA + kstep, voffA); PG8_STAGE(PG8_SB(1, 1), cB + hstepB + kstep, voffB);
        PG8_WAIT_V(6); PG8_BAR;
    } else {
        PG8_STAGE(PG8_SB(0, 0), cB, voffB); PG8_STAGE(PG8_SA(0, 0), cA, voffA); PG8_STAGE(PG8_SB(0, 1), cB + hstepB, voffB); PG8_STAGE(PG8_SA(0, 1), cA + hstepA, voffA);
        if (wr == 1) PG8_BAR;
        PG8_WAIT_V(4); PG8_BAR;
        PG8_STAGE(PG8_SB(1, 0), cB + kstep, voffB); PG8_STAGE(PG8_SA(1, 0), cA + kstep, voffA); PG8_STAGE(PG8_SB(1, 1), cB + hstepB + kstep, voffB);
        PG8_WAIT_V(6); PG8_BAR;
    }
    for (;;) {
        const bool has_next = S.next(ui + 1, nxt);
        const char* nA = has_next ? (const char*)g.A + (size_t)nxt.pm * tstepA : cA; const char* nB = has_next ? (const char*)g.Bt + (size_t)nxt.pn * tstepB : cB;
        for (int t = 0; t < nt; t += 2) {
            const bool last = (t == nt - 2);
            const char* a1 = cA + (size_t)(t + 1) * kstep;
            const char* a2 = last ? nA : cA + (size_t)(t + 2) * kstep; const char* b2 = last ? nB : cB + (size_t)(t + 2) * kstep;
            const char* a3 = a2 + kstep; const char* b3 = b2 + kstep;
            if (last && has_next) S.a_ready(nxt);
            if constexpr (SP2) {
            PG8_LDB(B0, 0, 0); PG8_LDB(B1, 0, 1); PG8_SCHED; PG8_LDA(At, 0, 0); PG8_STAGE(PG8_SA(1, 1), a1 + hstepA, voffA);
            PG8_WAIT_V(8); PG8_WAIT_L(0); PG8_BAR; PG8_MMA(0, 0, At, B0); PG8_MMA(0, 1, At, B1); PG8_BAR; PG8_SCHED;
            PG8_LDA(At, 0, 1); PG8_STAGE(PG8_SB(0, 0), b2, voffB); PG8_STAGE(PG8_SB(0, 1), b2 + hstepB, voffB); PG8_STAGE(PG8_SA(0, 0), a2, voffA);
            PG8_WAIT_V(8); PG8_WAIT_L(0); PG8_BAR; PG8_MMA(1, 0, At, B0); PG8_MMA(1, 1, At, B1); PG8_BAR; PG8_SCHED;
            PG8_LDB(B0, 1, 0); PG8_LDB(B1, 1, 1); PG8_SCHED; PG8_LDA(At, 1, 0); PG8_STAGE(PG8_SA(0, 1), a2 + hstepA, voffA);
            PG8_WAIT_V(8); PG8_WAIT_L(0); PG8_BAR; PG8_MMA(0, 0, At, B0); PG8_MMA(0, 1, At, B1); PG8_BAR; PG8_SCHED;
            PG8_LDA(At, 1, 1); PG8_STAGE(PG8_SB(1, 0), b3, voffB); PG8_STAGE(PG8_SB(1, 1), b3 + hstepB, voffB); PG8_STAGE(PG8_SA(1, 0), a3, voffA);
            PG8_WAIT_V(8); PG8_WAIT_L(0); PG8_BAR; PG8_MMA(1, 0, At, B0); PG8_MMA(1, 1, At, B1); PG8_BAR; PG8_SCHED;
            } else {
            PG8_LDB(B0, 0, 0); PG8_SCHED; PG8_LDA(At, 0, 0); PG8_STAGE(PG8_SA(1, 1), a1 + hstepA, voffA);
            PG8_WAIT_L(8); PG8_BAR; PG8_WAIT_L(0); PG8_MMA(0, 0, At, B0); PG8_BAR; PG8_SCHED;
            PG8_LDB(B1, 0, 1); PG8_STAGE(PG8_SB(0, 0), b2, voffB);
            PG8_BAR; PG8_WAIT_L(0); PG8_MMA(0, 1, At, B1); PG8_BAR;
            PG8_LDA(At, 0, 1); PG8_STAGE(PG8_SA(0, 0), a2, voffA);
            PG8_BAR; PG8_WAIT_L(0); PG8_MMA(1, 0, At, B0); PG8_BAR; PG8_SCHED;
            PG8_STAGE(PG8_SB(0, 1), b2 + hstepB, voffB);
            PG8_WAIT_V(6); PG8_BAR; PG8_MMA(1, 1, At, B1); PG8_BAR;
            PG8_LDB(B0, 1, 0); PG8_SCHED; PG8_LDA(At, 1, 0); PG8_STAGE(PG8_SA(0, 1), a2 + hstepA, voffA);
            PG8_WAIT_L(8); PG8_BAR; PG8_WAIT_L(0); PG8_MMA(0, 0, At, B0); PG8_BAR; PG8_SCHED;
            PG8_LDB(B1, 1, 1); PG8_STAGE(PG8_SB(1, 0), b3, voffB);
            PG8_BAR; PG8_WAIT_L(0); PG8_MMA(0, 1, At, B1); PG8_BAR;
            PG8_LDA(At, 1, 1); PG8_STAGE(PG8_SA(1, 0), a3, voffA);
            PG8_BAR; PG8_WAIT_L(0); PG8_MMA(1, 0, At, B0); PG8_BAR; PG8_SCHED;
            PG8_STAGE(PG8_SB(1, 1), b3 + hstepB, voffB);
            PG8_WAIT_V(6); PG8_BAR; PG8_MMA(1, 1, At, B1); PG8_BAR;
            }
        }
        if constexpr (ALIGN_EPI) { if (wr == 0) PG8_BAR; }
        if constexpr (!Epi::AFTER_DRAIN) { E(acc, cur, wr, wc, fr, fq); S.done(cur); }
        if (!has_next) break;
#pragma unroll
        for (int a = 0; a < 2; ++a)
#pragma unroll
            for (int b = 0; b < 2; ++b)
#pragma unroll
                for (int m = 0; m < 4; ++m)
#pragma unroll
                    for (int n = 0; n < 2; ++n) acc[a][b][m][n] = (f32x4){0.f, 0.f, 0.f, 0.f};
        cur = nxt; cA = nA; cB = nB; ++ui;
        if constexpr (ALIGN_EPI) { if (wr == 1) PG8_BAR; }
    }
    PG8_WAIT_V(0);
    if constexpr (!ALIGN_EPI) { if (wr == 0) PG8_BAR; }
    PG8_BAR;
    if constexpr (Epi::AFTER_DRAIN) { E.fused(acc, cur, wr, wc, fr, fq, lds, wid, lane); S.done(cur); }
#undef PG8_SA
#undef PG8_SB
#undef PG8_STAGE
#undef PG8_LDA
#undef PG8_LDB
#undef PG8_MMA
#undef PG8_WAIT_V
#undef PG8_WAIT_L
#undef PG8_BAR
#undef PG8_SCHED
}
}
#include <hip/hip_bf16.h>
#include <cmath>
namespace attn_body {
using bf16=__hip_bfloat16;
using bf16x8=__attribute__((ext_vector_type(8)))short;
using s16x4=__attribute__((ext_vector_type(4)))short;
using f32x16=__attribute__((ext_vector_type(16)))float;
using u32x4=__attribute__((ext_vector_type(4)))unsigned;
constexpr int BATCH=8,SEQ=2048,D=64,ZPI=4608,OPI=1024;
constexpr int NW=8,QBLK=32,QB=QBLK*NW,KVBLK=64,NQB=SEQ/QB;
constexpr int ATTN_UNIT_ROWS=QB;
__device__ __forceinline__ int crow(int r,int hi){return (r&3)+8*(r>>2)+4*hi;}
#define SBAR() __builtin_amdgcn_sched_barrier(0)
__device__ __forceinline__ void cmask(f32x16&p0,f32x16&p1,int jb,int qrel,int hi){
  const float NEG=-INFINITY; int kb=64*jb+4*hi;
  #pragma unroll
  for(int r=0;r<16;++r){int kv=kb+(r&3)+8*(r>>2); if(kv>qrel)p0[r]=NEG; if(kv+32>qrel)p1[r]=NEG;}
}

constexpr int NSLOT=3, SLOTB=8192;
constexpr int LDS_K=0, LDS_V=NSLOT*SLOTB, LDS_WS=2*NSLOT*SLOTB, LDS_OST=LDS_WS+NW*64*4, LDS_BYTES=LDS_OST+NW*4096;
constexpr float C2=0.125f*1.4426950408889634f;
__device__ __forceinline__ void glds16(const void*gsrc,unsigned lds_dst){unsigned keep;
  asm volatile("s_mov_b32 %0, m0\n\ts_mov_b32 m0, %2\n\ts_nop 0\n\tglobal_load_lds_dwordx4 %1, off\n\ts_mov_b32 m0, %0":"=&s"(keep):"v"(gsrc),"s"(lds_dst):"memory");}
__device__ __forceinline__ float max3f(float a,float b,float c){float r;asm("v_max3_f32 %0, %1, %2, %3":"=v"(r):"v"(a),"v"(b),"v"(c));return r;}
__device__ __forceinline__ float max2f(float a,float b){float r;asm("v_max_f32_e32 %0, %1, %2":"=v"(r):"v"(a),"v"(b));return r;}
__device__ __forceinline__ float fadd_s(float a,float b){float r;asm("v_add_f32_e32 %0, %1, %2":"=v"(r):"v"(a),"v"(b));return r;}
__device__ __forceinline__ float fsub_s(float a,float b){float r;asm("v_sub_f32_e32 %0, %1, %2":"=v"(r):"v"(a),"v"(b));return r;}
typedef float f32x2_t __attribute__((ext_vector_type(2))); typedef __bf16 bf16x2_t __attribute__((ext_vector_type(2)));
__device__ __forceinline__ unsigned cvtpk_s(float lo,float hi){f32x2_t v={lo,hi};bf16x2_t b=__builtin_convertvector(v,bf16x2_t);return __builtin_bit_cast(unsigned,b);}
#define WAIT_BAR(N) asm volatile("s_waitcnt vmcnt(" #N ") lgkmcnt(0)\n\ts_barrier":::"memory")

__device__ __forceinline__ void qkt(f32x16&p0,f32x16&p1,const char*Kslot,const bf16x8*qr,const f32x16&negm,int r32,int hi){
  const char*kb=Kslot+hi*1024+r32*16;
  #pragma unroll
  for(int d0=0;d0<4;++d0){
    const bf16x8 b0=*reinterpret_cast<const bf16x8*>(kb+d0*2048);
    const bf16x8 b1=*reinterpret_cast<const bf16x8*>(kb+d0*2048+512);
    if(d0==0){p0=__builtin_amdgcn_mfma_f32_32x32x16_bf16(b0,qr[0],negm,0,0,0);p1=__builtin_amdgcn_mfma_f32_32x32x16_bf16(b1,qr[0],negm,0,0,0);}
    else{p0=__builtin_amdgcn_mfma_f32_32x32x16_bf16(b0,qr[d0],p0,0,0,0);p1=__builtin_amdgcn_mfma_f32_32x32x16_bf16(b1,qr[d0],p1,0,0,0);}}
}
typedef __attribute__((address_space(3))) const char* lds_cptr;
typedef short v4i16_t __attribute__((ext_vector_type(4)));
__device__ __forceinline__ void kload8(bf16x8*kf,lds_cptr kp){
  kf[0]=*(const __attribute__((address_space(3))) bf16x8*)(kp);      kf[1]=*(const __attribute__((address_space(3))) bf16x8*)(kp+512);
  kf[2]=*(const __attribute__((address_space(3))) bf16x8*)(kp+2048); kf[3]=*(const __attribute__((address_space(3))) bf16x8*)(kp+2560);
  kf[4]=*(const __attribute__((address_space(3))) bf16x8*)(kp+4096); kf[5]=*(const __attribute__((address_space(3))) bf16x8*)(kp+4608);
  kf[6]=*(const __attribute__((address_space(3))) bf16x8*)(kp+6144); kf[7]=*(const __attribute__((address_space(3))) bf16x8*)(kp+6656);
}
__device__ __forceinline__ void kload2(bf16x8*kf,lds_cptr kp,int j){ kf[2*j]=*(const __attribute__((address_space(3))) bf16x8*)(kp+j*2048); kf[2*j+1]=*(const __attribute__((address_space(3))) bf16x8*)(kp+j*2048+512); }
__device__ __forceinline__ s16x4 vtr(lds_cptr p){ return __builtin_bit_cast(s16x4,__builtin_amdgcn_ds_read_tr16_b64_v4i16((__attribute__((address_space(3))) v4i16_t*)p)); }
__device__ __forceinline__ float rowmax(const f32x16&p0,const f32x16&p1){
  float a=max3f(p0[0],p0[1],p1[0]),b=max3f(p0[2],p0[3],p1[1]);a=max3f(a,p1[2],p1[3]);
  #pragma unroll
  for(int r=4;r<16;r+=4){a=max3f(a,p0[r],p0[r+1]);b=max3f(b,p0[r+2],p0[r+3]);a=max3f(a,p1[r],p1[r+1]);b=max3f(b,p1[r+2],p1[r+3]);}
  const float m=max2f(a,b);
  auto rr=__builtin_amdgcn_permlane32_swap(__float_as_uint(m),__float_as_uint(m),false,false);
  return max2f(__uint_as_float(rr[0]),__uint_as_float(rr[1]));
}
__device__ __forceinline__ void pv(f32x16*o,int vb,bf16x8 pa0,bf16x8 pa1,bf16x8 pa2,bf16x8 pa3){
  #pragma unroll
  for(int d0=0;d0<2;++d0){s16x4 lo[4],hi[4];
    #pragma unroll
    for(int ks=0;ks<4;++ks){
      asm volatile("ds_read_b64_tr_b16 %0,%1 offset:%c2":"=&v"(lo[ks]):"v"(vb),"i"(d0*4096+ks*1024):"memory");
      asm volatile("ds_read_b64_tr_b16 %0,%1 offset:%c2":"=&v"(hi[ks]):"v"(vb),"i"(d0*4096+ks*1024+512):"memory");}
    asm volatile("s_waitcnt lgkmcnt(0)":::"memory");SBAR();
    #define PK(k) (bf16x8){lo[k][0],lo[k][1],lo[k][2],lo[k][3],hi[k][0],hi[k][1],hi[k][2],hi[k][3]}
    o[d0]=__builtin_amdgcn_mfma_f32_32x32x16_bf16(pa0,PK(0),o[d0],0,0,0);
    o[d0]=__builtin_amdgcn_mfma_f32_32x32x16_bf16(pa1,PK(1),o[d0],0,0,0);
    o[d0]=__builtin_amdgcn_mfma_f32_32x32x16_bf16(pa2,PK(2),o[d0],0,0,0);
    o[d0]=__builtin_amdgcn_mfma_f32_32x32x16_bf16(pa3,PK(3),o[d0],0,0,0);
    #undef PK
  }
}

#ifndef ATTN_STORE16
#define ATTN_STORE16(p,v) (*(u32x4*)(p)=(v))
#endif
template<int THRL> __device__ __forceinline__ void attn_unit(int b,int qb,const bf16*Q,const bf16*__restrict__ K,const bf16*__restrict__ V,bf16*O,char*shm){
  int tid=threadIdx.x; asm volatile("":"+v"(tid)); const int lane=tid&63,r32=lane&31,hi=lane>>5; const int wid=__builtin_amdgcn_readfirstlane(tid>>6);
  const long rowbase=(long)b*SEQ; const int q0=qb*QB;
  const bf16*Qw=Q+(rowbase+q0+wid*QBLK)*ZPI;
  const bf16*Kh=K+rowbase*ZPI,*Vh=V+rowbase*ZPI;
  const unsigned lds0=(unsigned)(uintptr_t)shm;
  float*wsf=(float*)(shm+LDS_WS)+wid*64;
  const bf16*ksrc=Kh+(long)lane*ZPI+wid*8;
  const bf16*vsrc=Vh+(long)(16*(wid&3)+(lane>>2))*ZPI+(wid>>2)*32+(lane&3)*8;
  const unsigned kdst=lds0+LDS_K+wid*1024, vdst=lds0+LDS_V+wid*1024;
  #define DMA_K(t,slot) glds16(ksrc+(long)(t)*KVBLK*ZPI,(unsigned)__builtin_amdgcn_readfirstlane(kdst+(slot)))
  #define DMA_V(t,slot) glds16(vsrc+(long)(t)*KVBLK*ZPI,(unsigned)__builtin_amdgcn_readfirstlane(vdst+(slot)))
  const int vb0=(int)(lds0+LDS_V)+((lane>>4)&1)*32+(lane&3)*8+(4*hi+((lane&15)>>2))*64;
  const char*Kbase=shm+LDS_K; bf16x8 kf[8];
  const lds_cptr shm3=(lds_cptr)shm; const lds_cptr kp0=shm3+LDS_K+hi*1024+r32*16; const lds_cptr vp0=shm3+LDS_V+((lane>>4)&1)*32+(lane&3)*8+(4*hi+((lane&15)>>2))*64;
  const int NT=(q0+QB)/KVBLK;
  DMA_K(0,0);DMA_V(0,0);DMA_K(1,SLOTB);
  bf16x8 qr[4];
  #pragma unroll
  for(int d0=0;d0<4;++d0)qr[d0]=*reinterpret_cast<const bf16x8*>(&Qw[(long)r32*ZPI+d0*16+hi*8]);
  float mhat=0.f,l_reg=0.f;f32x16 o[2];o[0]=f32x16{};o[1]=f32x16{};f32x16 negm=f32x16{};asm volatile("":"+v"(negm));
  const int qrel=wid*QBLK+r32;
  #define CMASK(P0,P1,t) do{int jb_=(t)-(NT-4); if(jb_>=0)cmask(P0,P1,jb_,qrel,hi);}while(0)
  bool resc=false;
  #define START(P0,P1) do{ const float rm=rowmax(P0,P1); resc=false; \
    { const float dl=rm; mhat=fadd_s(mhat,dl); \
      _Pragma("unroll") for(int r=0;r<16;++r){P0[r]=fsub_s(P0[r],dl);P1[r]=fsub_s(P1[r],dl);} \
      _Pragma("unroll") for(int r=0;r<16;++r)negm[r]=-mhat; asm volatile("":"+v"(negm)); } \
    _Pragma("unroll") for(int r=0;r<16;++r)P0[r]=__builtin_amdgcn_exp2f(P0[r]); }while(0)
  #define RESC() do{ if(resc){ asm volatile("s_waitcnt lgkmcnt(0)":::"memory"); \
      _Pragma("unroll") for(int d_=0;d_<2;++d_) _Pragma("unroll") for(int r=0;r<16;++r)o[d_][r]*=wsf[crow(r,hi)]; } }while(0)
  f32x16 pA0,pA1,pB0,pB1;
  int sl_prev=0,sl_cur=0,sl_next=SLOTB;
  #define ROT() do{sl_prev=sl_cur;sl_cur=sl_next;sl_next=(sl_next==(NSLOT-1)*SLOTB)?0:sl_next+SLOTB;}while(0)
  DMA_K(2,2*SLOTB);
  WAIT_BAR(3);
  qkt(pA0,pA1,Kbase,qr,negm,r32,hi);asm volatile("s_nop 15\n\ts_nop 7":"+v"(pA0),"+v"(pA1));CMASK(pA0,pA1,0);
  START(pA0,pA1);
  _Pragma("unroll") for(int r=0;r<16;++r)pA1[r]=__builtin_amdgcn_exp2f(pA1[r]);
  WAIT_BAR(0);
  DMA_K(3,0);DMA_V(1,SLOTB);
  ROT();
  kload8(kf,kp0+sl_cur);
  WAIT_BAR(2);
  s16x4 vlo[8],vhi[8]; u32x4 pw0,pw1,pw2,pw3;
  #define PKW(P,B) cvtpk_s(P[B],P[B+1])
  #define PAF(k) __builtin_bit_cast(bf16x8,pw##k)
  #define VFR(i) (bf16x8){vlo[i][0],vlo[i][1],vlo[i][2],vlo[i][3],vhi[i][0],vhi[i][1],vhi[i][2],vhi[i][3]}
  #define PIN(x) asm volatile("":"+v"(x))
  #define MX3(a,b,c) __builtin_fmaxf(__builtin_fmaxf((a),(b)),(c))
  #define GAPA(MF,A0,A1,A2,A3,W0,W1,PW) do{ MF; sacc+=A0; sacc+=A1; sacc+=A2; sacc+=A3; PIN(sacc); W0; W1; PIN(PW); SBAR(); }while(0)
  #define EX(v) __builtin_amdgcn_exp2f(v)
  #define GAPB(MF,X,B) do{ MF; X[B]=EX(X[B]); X[B+1]=EX(X[B+1]); X[B+2]=EX(X[B+2]); X[B+3]=EX(X[B+3]); PIN(X); SBAR(); }while(0)
  #define VRD(i) do{ vlo[i]=vtr(vp_+(((i)>>2)*4096+((i)&3)*1024)); vhi[i]=vtr(vp_+(((i)>>2)*4096+((i)&3)*1024+512)); }while(0)
  #define KRD(G,j) do{ if(G){ kload2(kf,kp0+sl_next,j); SBAR(); } }while(0)
  #define STEP(C0,C1,P0,P1,t,GK,GV,GL) do{ SBAR(); \
    const lds_cptr vp_=vp0+sl_prev; \
    VRD(0); SBAR(); float sacc=(P0[0]+P0[1]); \
    GAPA(C0=__builtin_amdgcn_mfma_f32_32x32x16_bf16(kf[0],qr[0],negm,0,0,0), P0[2],P0[3],P0[4],P0[5],     pw0[0]=PKW(P0,0), pw0[1]=PKW(P0,2), pw0); \
    VRD(4); SBAR(); GAPA(C1=__builtin_amdgcn_mfma_f32_32x32x16_bf16(kf[1],qr[0],negm,0,0,0), P0[6],P0[7],P0[8],P0[9],     pw0[2]=PKW(P0,4), pw0[3]=PKW(P0,6), pw0); \
    VRD(1); SBAR(); GAPA(C0=__builtin_amdgcn_mfma_f32_32x32x16_bf16(kf[2],qr[1],C0,0,0,0),   P0[10],P0[11],P0[12],P0[13], pw1[0]=PKW(P0,8), pw1[1]=PKW(P0,10), pw1); \
    VRD(5); SBAR(); GAPA(C1=__builtin_amdgcn_mfma_f32_32x32x16_bf16(kf[3],qr[1],C1,0,0,0),   P0[14],P0[15],P1[0],P1[1],   pw1[2]=PKW(P0,12),pw1[3]=PKW(P0,14), pw1); \
    VRD(2); SBAR(); GAPA(C0=__builtin_amdgcn_mfma_f32_32x32x16_bf16(kf[4],qr[2],C0,0,0,0),   P1[2],P1[3],P1[4],P1[5],     pw2[0]=PKW(P1,0), pw2[1]=PKW(P1,2), pw2); \
    VRD(6); SBAR(); GAPA(C1=__builtin_amdgcn_mfma_f32_32x32x16_bf16(kf[5],qr[2],C1,0,0,0),   P1[6],P1[7],P1[8],P1[9],     pw2[2]=PKW(P1,4), pw2[3]=PKW(P1,6), pw2); \
    VRD(3); SBAR(); GAPA(C0=__builtin_amdgcn_mfma_f32_32x32x16_bf16(kf[6],qr[3],C0,0,0,0),   P1[10],P1[11],P1[12],P1[13], pw3[0]=PKW(P1,8), pw3[1]=PKW(P1,10), pw3); \
    VRD(7); SBAR(); GAPA(C1=__builtin_amdgcn_mfma_f32_32x32x16_bf16(kf[7],qr[3],C1,0,0,0),   P1[14],P1[15],0.f,0.f,       pw3[2]=PKW(P1,12),pw3[3]=PKW(P1,14), pw3); \
    l_reg+=sacc; \
    if(GK){DMA_K((t)+3,sl_cur);} if(GV){DMA_V((t)+1,sl_next);} \
    CMASK(C0,C1,t); \
    { float a=MX3(C0[0],C0[1],C1[0]),b=MX3(C0[2],C0[3],C1[1]); a=MX3(a,C1[2],C1[3]); \
      _Pragma("unroll") for(int r=4;r<16;r+=4){a=MX3(a,C0[r],C0[r+1]);b=MX3(b,C0[r+2],C0[r+3]);a=MX3(a,C1[r],C1[r+1]);b=MX3(b,C1[r+2],C1[r+3]);} \
      float rm=__builtin_fmaxf(a,b); { auto rr=__builtin_amdgcn_permlane32_swap(__float_as_uint(rm),__float_as_uint(rm),false,false); rm=__builtin_fmaxf(__uint_as_float(rr[0]),__uint_as_float(rr[1])); } \
      resc=false; \
      if(__builtin_expect(__any(rm>(float)THRL),0)){ const float dl=__builtin_fmaxf(rm,0.f); mhat+=dl; \
        _Pragma("unroll") for(int r=0;r<16;++r){C0[r]-=dl;C1[r]-=dl;} \
        _Pragma("unroll") for(int r=0;r<16;++r)negm[r]=-mhat; asm volatile("":"+v"(negm)); \
        const float f=__builtin_amdgcn_exp2f(-dl); l_reg*=f; if(hi==0)wsf[r32]=f; resc=true; } } \
    SBAR(); \
    GAPB(o[0]=__builtin_amdgcn_mfma_f32_32x32x16_bf16(PAF(0),VFR(0),o[0],0,0,0), C0,0); \
    GAPB(o[1]=__builtin_amdgcn_mfma_f32_32x32x16_bf16(PAF(0),VFR(4),o[1],0,0,0), C0,4); \
    KRD(GL,0); GAPB(o[0]=__builtin_amdgcn_mfma_f32_32x32x16_bf16(PAF(1),VFR(1),o[0],0,0,0), C0,8); \
    KRD(GL,1); GAPB(o[1]=__builtin_amdgcn_mfma_f32_32x32x16_bf16(PAF(1),VFR(5),o[1],0,0,0), C0,12); \
    KRD(GL,2); GAPB(o[0]=__builtin_amdgcn_mfma_f32_32x32x16_bf16(PAF(2),VFR(2),o[0],0,0,0), C1,0); \
    KRD(GL,3); GAPB(o[1]=__builtin_amdgcn_mfma_f32_32x32x16_bf16(PAF(2),VFR(6),o[1],0,0,0), C1,4); \
    GAPB(o[0]=__builtin_amdgcn_mfma_f32_32x32x16_bf16(PAF(3),VFR(3),o[0],0,0,0), C1,8); \
    GAPB(o[1]=__builtin_amdgcn_mfma_f32_32x32x16_bf16(PAF(3),VFR(7),o[1],0,0,0), C1,12); \
    }while(0)
  int t=1;
  #undef CMASK
  #define CMASK(P0,P1,t) do{}while(0)
  for(;t+5<NT;t+=2){
    STEP(pB0,pB1,pA0,pA1,t,true,true,true);     WAIT_BAR(2); RESC(); ROT();
    STEP(pA0,pA1,pB0,pB1,t+1,true,true,true);   WAIT_BAR(2); RESC(); ROT();
  }
  #undef CMASK
  #define CMASK(P0,P1,t) do{int jb_=(t)-(NT-4); if(jb_>=0)cmask(P0,P1,jb_,qrel,hi);}while(0)
  #define ENDW(tt) do{ if((tt)+3<NT){WAIT_BAR(2);} else if((tt)+2<NT){WAIT_BAR(1);} else {WAIT_BAR(0);} }while(0)
  for(;t+1<NT;t+=2){
    STEP(pB0,pB1,pA0,pA1,t,(t+3<NT),(t+1<NT),(t+1<NT));       ENDW(t);   RESC(); ROT();
    STEP(pA0,pA1,pB0,pB1,t+1,(t+4<NT),(t+2<NT),(t+2<NT));     ENDW(t+1); RESC(); ROT();
  }
  STEP(pB0,pB1,pA0,pA1,NT-1,false,false,false); RESC();
  { float sacc=pB0[0]+pB0[1]; _Pragma("unroll") for(int r=2;r<16;++r)sacc+=pB0[r]; _Pragma("unroll") for(int r=0;r<16;++r)sacc+=pB1[r]; l_reg+=sacc;
    pw0=(u32x4){PKW(pB0,0),PKW(pB0,2),PKW(pB0,4),PKW(pB0,6)};pw1=(u32x4){PKW(pB0,8),PKW(pB0,10),PKW(pB0,12),PKW(pB0,14)};pw2=(u32x4){PKW(pB1,0),PKW(pB1,2),PKW(pB1,4),PKW(pB1,6)};pw3=(u32x4){PKW(pB1,8),PKW(pB1,10),PKW(pB1,12),PKW(pB1,14)};
    SBAR(); pv(o,vb0+sl_cur,PAF(0),PAF(1),PAF(2),PAF(3)); }
  #undef PKW
  #undef PAF
  #undef VFR
  #undef PIN
  #undef MX3
  #undef GAPA
  #undef GAPB
  #undef EX
  #undef VRD
  #undef KRD
  #undef STEP
  #undef ENDW
  {auto rr=__builtin_amdgcn_permlane32_swap(__float_as_uint(l_reg),__float_as_uint(l_reg),false,false);l_reg=__uint_as_float(rr[0])+__uint_as_float(rr[1]);}
  if(hi==0)wsf[32+r32]=l_reg;asm volatile("s_waitcnt lgkmcnt(0)":::"memory");
  float rli[16];
  #pragma unroll
  for(int r=0;r<16;++r)rli[r]=__builtin_amdgcn_rcpf(wsf[32+crow(r,hi)]);
  bf16*Ow=O+(rowbase+q0+wid*QBLK)*OPI;
  { bf16*stg=(bf16*)(shm+LDS_OST)+wid*2048;
    #pragma unroll
    for(int r=0;r<16;++r){const int orow=crow(r,hi);
      #pragma unroll
      for(int d0=0;d0<2;++d0)stg[orow*64+d0*32+r32]=__float2bfloat16(o[d0][r]*rli[r]);}
    asm volatile("s_waitcnt lgkmcnt(0)":::"memory");
    #pragma unroll
    for(int i=0;i<4;++i){const int row=i*8+(lane>>3),ch=lane&7; const u32x4 v=*(const u32x4*)(stg+row*64+ch*8); ATTN_STORE16(Ow+(long)row*OPI+ch*8,v);} }
  asm volatile("s_waitcnt lgkmcnt(0)\n\ts_barrier":::"memory");
  #undef DMA_K
  #undef DMA_V
  #undef CMASK
  #undef START
  #undef RESC
  #undef ROT
}
constexpr int ATTN_LDS_BYTES=LDS_BYTES;
#undef SBAR
#undef WAIT_BAR
}

namespace cg = cooperative_groups;
#ifndef PROBE_SEL
#define PROBE_SEL 0
#endif
#define LAS __attribute__((address_space(3)))
typedef unsigned short bf16;
typedef unsigned v4u __attribute__((ext_vector_type(4)));
typedef unsigned v2u __attribute__((ext_vector_type(2)));
typedef float f32x4 __attribute__((ext_vector_type(4)));
typedef short bf16x8 __attribute__((ext_vector_type(8)));

constexpr int NWAVES = 8;
constexpr int M = 16384, DM = 1024, SEQ = 2048, NBATCH = 8, ZP = 4608, UP = 5632, DFF = 2816, DIN = 4616, DMIX = 1536;
constexpr int DEPTH = 2;
constexpr float EPS = 1e-6f;
constexpr size_t MiB = 1u << 20;
constexpr size_t WS_CTL = 0;
constexpr size_t WS_RSTD = 64 * 1024;
constexpr size_t WS_RGSS = 128 * 1024;
constexpr size_t WS_GATES = 1 * MiB;
constexpr size_t WS_ROPE = 2 * MiB;
constexpr size_t WS_HALO = 3 * MiB;
constexpr size_t WS_WIN = 9 * MiB;
constexpr size_t WS_WOUT = 18 * MiB + 512 * 1024;
constexpr size_t WS_WUP = 21 * MiB + 512 * 1024;
constexpr size_t WS_WDN = 32 * MiB + 512 * 1024;
constexpr size_t WS_SSA = 192 * 1024;
constexpr size_t WS_XB = 38 * MiB;
constexpr size_t WS_BIG = 70 * MiB;
constexpr size_t WS_UHEAD = 246 * MiB;
constexpr size_t WS_ZHALO = 252 * MiB;
constexpr size_t WS_MLW = WS_BIG + 144 * MiB;
constexpr size_t WS_MLS = WS_BIG + 152 * MiB;
constexpr size_t WS_RGA = WS_BIG + 153 * MiB;
constexpr size_t WS_RGSUM = WS_BIG + 169 * MiB;
constexpr size_t WS_RGHIN = WS_BIG + 170 * MiB;
constexpr size_t WS_MCH = WS_RGHIN + 768 * 1024;
constexpr size_t WS_END = 256 * MiB;
constexpr int LDS_BYTES = 147456, MISC_OFF = 147200;

struct Params {
    const float* x; const int* pos; const float* attn_norm; const float* w_in; const float* rg_conv_w; const float* rg_conv_b; const float* rg_wa; const float* rg_ba;
    const float* rg_wx; const float* rg_bx; const float* rg_lambda; const float* rg_norm; const float* da_lambda; const float* da_norm; const float* ml_conv_w; const float* ml_conv_b;
    const float* ml_i_bias; const float* ml_f_bias; const float* ml_norm; const float* w_out; const float* mlp_norm; const float* w_up; const float* ffn_conv_w; const float* ffn_conv_b;
    const float* w_down; const float* final_norm; float* out; unsigned char* ws;
};

__device__ __forceinline__ unsigned f2bf(float f) { unsigned u = __builtin_bit_cast(unsigned, f); return (u + 0x7fffu + ((u >> 16) & 1u)) >> 16; }
typedef float f32x2_t_ __attribute__((ext_vector_type(2))); typedef __bf16 bf16x2_t_ __attribute__((ext_vector_type(2)));
__device__ __forceinline__ unsigned pk2(float lo, float hi) { f32x2_t_ v = {lo, hi}; bf16x2_t_ b = __builtin_convertvector(v, bf16x2_t_); return __builtin_bit_cast(unsigned, b); }
__device__ __forceinline__ float bflo(unsigned w) { return __uint_as_float(w << 16); }
__device__ __forceinline__ float bfhi(unsigned w) { return __uint_as_float(w & 0xffff0000u); }
__device__ __forceinline__ float wave_sum(float v) {
#pragma unroll
    for (int o = 1; o < 64; o <<= 1) v += __shfl_xor(v, o);
    return v;
}
__device__ __forceinline__ float sigmoidf_(float x) { return __builtin_amdgcn_rcpf(1.f + __expf(-x)); }
__device__ __forceinline__ float logsigmoidf_(float x) { return fminf(x, 0.f) - log1pf(__expf(-fabsf(x))); }
__device__ __forceinline__ float gelu_tanh(float x) { const float y = 0.7978845608028654f * (x + 0.044715f * x * x * x); const float t = 1.f - 2.f * __builtin_amdgcn_rcpf(1.f + __expf(2.f * y)); return 0.5f * x * (1.f + t); }
__device__ __forceinline__ void lds_addf(LAS float* p, float v) { __hip_atomic_fetch_add(p, v, __ATOMIC_RELAXED, __HIP_MEMORY_SCOPE_WORKGROUP); }
template <int CTRL, int RM> __device__ __forceinline__ float dpp_old(float old, float v) { return __int_as_float(__builtin_amdgcn_update_dpp(__float_as_int(old), __float_as_int(v), CTRL, RM, 0xf, false)); }
__device__ __forceinline__ float wave_incl_sum(float v) {
    v += dpp_old<0x111, 0xf>(0.f, v); v += dpp_old<0x112, 0xf>(0.f, v); v += dpp_old<0x114, 0xf>(0.f, v); v += dpp_old<0x118, 0xf>(0.f, v);
    v += dpp_old<0x142, 0xa>(0.f, v); v += dpp_old<0x143, 0xc>(0.f, v); return v; }
__device__ __forceinline__ float wave_incl_max(float v) {
    const float ninf = -__builtin_inff();
    v = fmaxf(v, dpp_old<0x111, 0xf>(ninf, v)); v = fmaxf(v, dpp_old<0x112, 0xf>(ninf, v)); v = fmaxf(v, dpp_old<0x114, 0xf>(ninf, v)); v = fmaxf(v, dpp_old<0x118, 0xf>(ninf, v));
    v = fmaxf(v, dpp_old<0x142, 0xa>(ninf, v)); v = fmaxf(v, dpp_old<0x143, 0xc>(ninf, v)); return v; }
#define MFMA16(a, b, c) __builtin_amdgcn_mfma_f32_16x16x32_bf16((a), (b), (c), 0, 0, 0)
#define XB_TMO      128
#define XB_XCNT(j)  (256  + 64 * (j))
#define XB_XSUB(j)  (1280 + 64 * (j))
#define XB_XGEN(j)  (2304 + 64 * (j))
#define XB_TOP      3328
#define XB_TOPGEN   3392
#define XCD_BAR_WORDS 3456
#define XB_SPIN_CAP (1u << 18)

__device__ __forceinline__ unsigned xb_ld(unsigned* p)              { return __hip_atomic_load(p, __ATOMIC_RELAXED, __HIP_MEMORY_SCOPE_AGENT); }
__device__ __forceinline__ unsigned xb_add(unsigned* p, unsigned v) { return __hip_atomic_fetch_add(p, v, __ATOMIC_RELAXED, __HIP_MEMORY_SCOPE_AGENT); }
__device__ __forceinline__ unsigned xb_xcc_id() { return (unsigned)__builtin_amdgcn_s_getreg((3 << 11) | 20) & 0xFu; }
#define XB_SPIN(cond, bar) do { unsigned _sp = 0; while (cond) { __builtin_amdgcn_s_sleep(1); \
    if ((++_sp & 255u) == 0u) { if (xb_ld(&(bar)[XB_TMO])) break; if (_sp > XB_SPIN_CAP) { atomicAdd(&(bar)[XB_TMO], 1u); break; } } } } while (0)

struct XcdBarrier {
    unsigned* bar; unsigned x;
    volatile LAS unsigned* st;
};

__device__ __forceinline__ XcdBarrier xcd_barrier_post(unsigned* bar, volatile LAS unsigned* st) {
    XcdBarrier b; b.bar = bar; b.x = xb_xcc_id(); b.st = st;
    if (threadIdx.x == 0) (void)xb_add(&bar[XB_XCNT(b.x)], 1u);
    return b;
}
__device__ __forceinline__ void xcd_barrier_complete(unsigned* bar, unsigned x, unsigned& nloc, unsigned& nx) {
    const unsigned G = gridDim.x * gridDim.y * gridDim.z;
    unsigned sum, cnt, mine, sp = 0u;
    for (;;) {
        sum = 0u; cnt = 0u; mine = 0u;
#pragma unroll
        for (unsigned j = 0; j < 16; ++j) { const unsigned c = xb_ld(&bar[XB_XCNT(j)]); sum += c; cnt += (c > 0u) ? 1u : 0u; mine = (j == x) ? c : mine; }
        if (sum == G) break;
        __builtin_amdgcn_s_sleep(1);
        if ((++sp & 255u) == 0u) { if (xb_ld(&bar[XB_TMO])) break; if (sp > XB_SPIN_CAP) { atomicAdd(&bar[XB_TMO], 1u); break; } }
    }
    nloc = mine > 0u ? mine : 1u; nx = cnt > 0u ? cnt : 1u;
}

__device__ __forceinline__ void xcd_barrier(const XcdBarrier& b) {
    asm volatile("s_waitcnt vmcnt(0)" ::: "memory");
    __syncthreads();
    if (threadIdx.x == 0) {
        unsigned* bar = b.bar;
        __builtin_amdgcn_s_waitcnt(0);
        unsigned nloc = b.st[0], nx = b.st[1];
        if (nloc == 0u) { xcd_barrier_complete(bar, b.x, nloc, nx); b.st[0] = nloc; b.st[1] = nx; }
        const unsigned old = xb_add(&bar[XB_XSUB(b.x)], 1u);
        const unsigned gen = old / nloc;
        if (old + 1u == (gen + 1u) * nloc) {
            __builtin_amdgcn_fence(__ATOMIC_RELEASE, "agent");
            asm volatile("s_waitcnt vmcnt(0)" ::: "memory");
            const unsigned og = xb_add(&bar[XB_TOP], 1u);
            const unsigned tg = og / nx;
            if (og + 1u == (tg + 1u) * nx) xb_add(&bar[XB_TOPGEN], 1u);
            else XB_SPIN(xb_ld(&bar[XB_TOPGEN]) == tg, bar);
            __builtin_amdgcn_fence(__ATOMIC_ACQUIRE, "agent");
            xb_add(&bar[XB_XGEN(b.x)], 1u);
            asm volatile("s_waitcnt vmcnt(0)" ::: "memory");
        } else {
            XB_SPIN(xb_ld(&bar[XB_XGEN(b.x)]) == gen, bar);
            __builtin_amdgcn_fence(__ATOMIC_ACQUIRE, "agent");
            asm volatile("s_waitcnt vmcnt(0)" ::: "memory");
        }
    }
    __syncthreads();
}


__device__ __forceinline__ void transpose_item(const float* W, int ldw, int srccol, const float* gain, bf16* WT, int K, int dstrow, LAS float* scr, int k0, int lane, int nvalid = 32) {
    float tv[32];
#pragma unroll
    for (int i = 0; i < 32; ++i) { const int kk = 2 * i + (lane >> 5); tv[i] = ((lane & 31) < nvalid) ? W[(size_t)(k0 + kk) * ldw + srccol + (lane & 31)] : 0.f; }
    if (gain) {
#pragma unroll
        for (int i = 0; i < 32; ++i) tv[i] *= gain[k0 + 2 * i + (lane >> 5)]; }
#pragma unroll
    for (int i = 0; i < 32; ++i) scr[(2 * i + (lane >> 5)) * 33 + (lane & 31)] = tv[i];
    asm volatile("s_waitcnt lgkmcnt(0)" ::: "memory");
    const int c = lane & 7;
#pragma unroll
    for (int j = 0; j < 4; ++j) { const int n = (lane >> 3) + 8 * j; const LAS float* s = scr + (8 * c) * 33 + n;
        v4u o; o.x = pk2(s[0 * 33], s[1 * 33]); o.y = pk2(s[2 * 33], s[3 * 33]); o.z = pk2(s[4 * 33], s[5 * 33]); o.w = pk2(s[6 * 33], s[7 * 33]);
        *(v4u*)(WT + (size_t)(dstrow + n) * K + k0 + 8 * c) = o; }
    asm volatile("s_waitcnt lgkmcnt(0)" ::: "memory");
}
__device__ __forceinline__ int zcol_to_orig(int n0) {
    const int blk = n0 >> 9, r = n0 & 511;
    const int o = blk == 0 ? 0 : blk == 1 ? 512 : blk == 2 ? 1024 : blk == 3 ? 4096 : blk == 4 ? 1536 : blk == 5 ? 2048 : blk == 6 ? 2560 : blk == 7 ? 3072 : 3584;
    return o + r;
}
template <int PART> __device__ __forceinline__ void convert_weights(const Params& P, int l, LAS unsigned char* lds, int gw, int NGW, int wave, int lane) {
    LAS float* scr = (LAS float*)(lds + wave * 16384);
    constexpr int I_IN = 16 * 152, I_OUT = 24 * 32, I_UP = 16 * 176, I_DN = 44 * 32, NITEMS = I_IN + I_OUT + I_UP + I_DN;
    unsigned char* ws = P.ws;
    for (int it = (PART == 0 ? 0 : I_IN) + gw; it < (PART == 0 ? I_IN : NITEMS); it += NGW) {
        int r = it;
        if (r < I_IN) { const int kb = r / 152, nb = r % 152; transpose_item(P.w_in + (size_t)l * DM * DIN, DIN, nb < 144 ? zcol_to_orig(32 * nb) : 4608, P.attn_norm + l * DM, (bf16*)(ws + WS_WIN), DM, 32 * nb, scr, 64 * kb, lane, nb < 144 ? 32 : (nb == 144 ? 8 : 0)); continue; } r -= I_IN;
        if (r < I_OUT) { const int kb = r / 32, nb = r % 32; transpose_item(P.w_out + (size_t)l * DMIX * DM, DM, 32 * nb, nullptr, (bf16*)(ws + WS_WOUT), DMIX, 32 * nb, scr, 64 * kb, lane); continue; } r -= I_OUT;
        if (r < I_UP) { const int kb = r / 176, nb = r % 176; transpose_item(P.w_up + (size_t)l * DM * UP, UP, ((32 * nb) & 255) < 128 ? ((32 * nb) >> 8) * 128 + ((32 * nb) & 255) : DFF + ((32 * nb) >> 8) * 128 + ((32 * nb) & 255) - 128, P.mlp_norm + l * DM, (bf16*)(ws + WS_WUP), DM, 32 * nb, scr, 64 * kb, lane); continue; } r -= I_UP;
        { const int kb = r / 32, nb = r % 32; transpose_item(P.w_down + (size_t)l * DFF * DM, DM, 32 * nb, nullptr, (bf16*)(ws + WS_WDN), DFF, 32 * nb, scr, 64 * kb, lane); }
    }
}
template <bool GATES> __device__ __forceinline__ void rowpass(const float* x, bf16* xb, float* rstd, const LAS float* wgT, float* gates, int gw, int NGW, int lane) {
    for (int m = gw; m < M; m += 2 * NGW) {
        const int m2 = m + NGW; const bool has2 = m2 < M;
        const f32x4* xr = (const f32x4*)(x + (size_t)m * DM) + lane; const f32x4* xr2 = (const f32x4*)(x + (size_t)(has2 ? m2 : m) * DM) + lane;
        f32x4 v[4], w[4]; float s = 0.f, s2 = 0.f;
#pragma unroll
        for (int j = 0; j < 4; ++j) { v[j] = xr[64 * j]; w[j] = xr2[64 * j]; }
#pragma unroll
        for (int j = 0; j < 4; ++j) { s += (v[j].x * v[j].x + v[j].y * v[j].y) + (v[j].z * v[j].z + v[j].w * v[j].w); s2 += (w[j].x * w[j].x + w[j].y * w[j].y) + (w[j].z * w[j].z + w[j].w * w[j].w); }
        s = wave_sum(s); s2 = wave_sum(s2);
        if (lane == 0) { rstd[m] = s; if (has2) rstd[m2] = s2; }
        unsigned long long* o8 = (unsigned long long*)(xb + (size_t)m * DM) + lane;
#pragma unroll
        for (int j = 0; j < 4; ++j) o8[64 * j] = (unsigned long long)pk2(v[j].x, v[j].y) | ((unsigned long long)pk2(v[j].z, v[j].w) << 32);
        if (has2) { unsigned long long* p8 = (unsigned long long*)(xb + (size_t)m2 * DM) + lane;
#pragma unroll
            for (int j = 0; j < 4; ++j) p8[64 * j] = (unsigned long long)pk2(w[j].x, w[j].y) | ((unsigned long long)pk2(w[j].z, w[j].w) << 32); }
    }
}
__device__ __forceinline__ void finalize_mixers(const Params& P, int l, int gw, int NGW, int lane) {
    bf16* z = (bf16*)(P.ws + WS_BIG); const bf16* op = (const bf16*)(P.ws + WS_XB); const bf16* rga = (const bf16*)(P.ws + WS_RGA); const float* hin = (const float*)(P.ws + WS_RGHIN);
    const float lambda_init = 0.8f - 0.6f * expf(-0.3f * (float)l);
    const float* lp = P.da_lambda + l * 256;
    const float lam = expf(wave_sum(lp[lane] * lp[64 + lane])) - expf(wave_sum(lp[128 + lane] * lp[192 + lane])) + lambda_init;
    const float* gr = P.rg_norm + l * 512 + 8 * lane; const float* gd = P.da_norm + l * 128 + (lane & 15) * 8;
    float grg[8], gda[8];
#pragma unroll
    for (int i = 0; i < 8; ++i) { grg[i] = gr[i]; gda[i] = gd[i] * (1.f - lambda_init); }
    const int hh = lane >> 4, colw = (lane & 15) * 8, e = colw >> 6, d = colw & 63;
    v4u c_hw, c_aw, c_gw, c_a, c_b, n_hw, n_aw, n_gw, n_a, n_b; f32x4 c_h0, c_h1, n_h0, n_h1;
#define FM_LOAD(MM, HW, AW, GW, H0, H1, A_, B_) do { const bf16* zr_ = z + (size_t)(MM) * ZP; const int bb_ = (MM) >> 11, cc_ = ((MM) & 2047) >> 6; \
        HW = *(const v4u*)(zr_ + 8 * lane); AW = *(const v4u*)(rga + (size_t)(MM) * 512 + 8 * lane); GW = *(const v4u*)(zr_ + 512 + 8 * lane); \
        { const float* hp_ = hin + (size_t)(bb_ * 32 + cc_) * 512 + 8 * lane; H0 = *(const f32x4*)hp_; H1 = *(const f32x4*)(hp_ + 4); } \
        A_ = *(const v4u*)(op + (size_t)(MM) * DM + ((hh * 2 + 0) * 2 + e) * 64 + d); B_ = *(const v4u*)(op + (size_t)(MM) * DM + ((hh * 2 + 1) * 2 + e) * 64 + d); } while (0)
    if (gw < M) FM_LOAD(gw, c_hw, c_aw, c_gw, c_h0, c_h1, c_a, c_b);
    for (int m = gw; m < M; m += NGW) {
        bf16* zr = z + (size_t)m * ZP;
        const int mn = m + NGW;
        if (mn < M) FM_LOAD(mn, n_hw, n_aw, n_gw, n_h0, n_h1, n_a, n_b);
        { const v4u hw = c_hw, aw = c_aw, gw_ = c_gw; const f32x4 h0 = c_h0, h1 = c_h1;
          const float hl[8] = {bflo(hw.x), bfhi(hw.x), bflo(hw.y), bfhi(hw.y), bflo(hw.z), bfhi(hw.z), bflo(hw.w), bfhi(hw.w)};
          const float ap[8] = {bflo(aw.x), bfhi(aw.x), bflo(aw.y), bfhi(aw.y), bflo(aw.z), bfhi(aw.z), bflo(aw.w), bfhi(aw.w)};
          const float gt[8] = {bflo(gw_.x), bfhi(gw_.x), bflo(gw_.y), bfhi(gw_.y), bflo(gw_.z), bfhi(gw_.z), bflo(gw_.w), bfhi(gw_.w)};
          const float hi8[8] = {h0.x, h0.y, h0.z, h0.w, h1.x, h1.y, h1.z, h1.w};
          float y[8], ssum = 0.f;
#pragma unroll
          for (int i = 0; i < 8; ++i) { y[i] = gelu_tanh(gt[i]) * (hl[i] + ap[i] * hi8[i]); ssum += y[i] * y[i]; }
          ssum = wave_sum(ssum);
          const float rn = 1.f / sqrtf(ssum * (1.f / 512.f) + EPS); v4u o;
          o.x = pk2(y[0] * rn * grg[0], y[1] * rn * grg[1]); o.y = pk2(y[2] * rn * grg[2], y[3] * rn * grg[3]);
          o.z = pk2(y[4] * rn * grg[4], y[5] * rn * grg[5]); o.w = pk2(y[6] * rn * grg[6], y[7] * rn * grg[7]);
          *(v4u*)(zr + 512 + 8 * lane) = o; }
        { const v4u a = c_a, b = c_b; float o[8];
          o[0] = bflo(a.x) - lam * bflo(b.x); o[1] = bfhi(a.x) - lam * bfhi(b.x); o[2] = bflo(a.y) - lam * bflo(b.y); o[3] = bfhi(a.y) - lam * bfhi(b.y);
          o[4] = bflo(a.z) - lam * bflo(b.z); o[5] = bfhi(a.z) - lam * bfhi(b.z); o[6] = bflo(a.w) - lam * bflo(b.w); o[7] = bfhi(a.w) - lam * bfhi(b.w);
          float s_ = 0.f;
#pragma unroll
          for (int i = 0; i < 8; ++i) s_ += o[i] * o[i];
          s_ += __shfl_xor(s_, 1); s_ += __shfl_xor(s_, 2); s_ += __shfl_xor(s_, 4); s_ += __shfl_xor(s_, 8);
          const float rn = 1.f / sqrtf(s_ * (1.f / 128.f) + EPS); v4u w;
          w.x = pk2(o[0] * rn * gda[0], o[1] * rn * gda[1]); w.y = pk2(o[2] * rn * gda[2], o[3] * rn * gda[3]); w.z = pk2(o[4] * rn * gda[4], o[5] * rn * gda[5]); w.w = pk2(o[6] * rn * gda[6], o[7] * rn * gda[7]);
          *(v4u*)(zr + 1024 + hh * 128 + colw) = w; }
        c_hw = n_hw; c_aw = n_aw; c_gw = n_gw; c_h0 = n_h0; c_h1 = n_h1; c_a = n_a; c_b = n_b;
    }
#undef FM_LOAD
}
__device__ __forceinline__ void conv_gate(const Params& P, int l, int tid, int rc0, int rc1, int rcs) {
    asm volatile("" : "+v"(tid));
    bf16* H = (bf16*)(P.ws + WS_BIG); const bf16* halo = (const bf16*)(P.ws + WS_HALO); const bf16* uhead = (const bf16*)(P.ws + WS_UHEAD);
    const float* cw = P.ffn_conv_w + (size_t)l * 3 * UP; const float* cb = P.ffn_conv_b + (size_t)l * UP;
    for (int rc = rc0; rc < rc1; rc += rcs) {
        for (int p = tid; p < DFF / 2; p += NWAVES * 64) {
            const int c = 2 * p;
            float g[4][2], v[4][2];
#pragma unroll
            for (int q = 0; q < 2; ++q) { g[0][q] = 0.f; g[1][q] = 0.f; v[0][q] = 0.f; v[1][q] = 0.f; }
            if ((rc & 31) != 0) { const bf16* hp = halo + (size_t)(rc - 1) * 2 * UP;
                const unsigned a = *(const unsigned*)(hp + c), b = *(const unsigned*)(hp + UP + c), cc = *(const unsigned*)(hp + DFF + c), dd = *(const unsigned*)(hp + UP + DFF + c);
                g[0][0] = bflo(a); g[0][1] = bfhi(a); g[1][0] = bflo(b); g[1][1] = bfhi(b); v[0][0] = bflo(cc); v[0][1] = bfhi(cc); v[1][0] = bflo(dd); v[1][1] = bfhi(dd); }
            { const bf16* hp = uhead + (size_t)rc * 2 * UP;
                const unsigned a = *(const unsigned*)(hp + c), b = *(const unsigned*)(hp + UP + c), cc = *(const unsigned*)(hp + DFF + c), dd = *(const unsigned*)(hp + UP + DFF + c);
                g[2][0] = bflo(a); g[2][1] = bfhi(a); g[3][0] = bflo(b); g[3][1] = bfhi(b); v[2][0] = bflo(cc); v[2][1] = bfhi(cc); v[3][0] = bflo(dd); v[3][1] = bfhi(dd); }
#pragma unroll
            for (int t = 0; t < 2; ++t) { float hid[2];
#pragma unroll
                for (int q = 0; q < 2; ++q) { const float ug = cw[c + q] * g[t][q] + cw[UP + c + q] * g[t + 1][q] + cw[2 * UP + c + q] * g[t + 2][q] + cb[c + q];
                    const float uv = cw[DFF + c + q] * v[t][q] + cw[UP + DFF + c + q] * v[t + 1][q] + cw[2 * UP + DFF + c + q] * v[t + 2][q] + cb[DFF + c + q];
                    hid[q] = ug * sigmoidf_(ug) * uv; }
                *(unsigned*)(H + ((size_t)rc * 64 + t) * DFF + c) = pk2(hid[0], hid[1]); }
        }
    }
}
__device__ __forceinline__ void final_norm(const Params& P, int gw, int NGW, int lane, float* dst) {
    f32x4 g[4];
#pragma unroll
    for (int j = 0; j < 4; ++j) g[j] = ((const f32x4*)P.final_norm)[64 * j + lane];
    for (int m = gw; m < M; m += 2 * NGW) {
        const int m2 = m + NGW; const bool has2 = m2 < M;
        const f32x4* xr = (const f32x4*)(P.out + (size_t)m * DM) + lane; const f32x4* xr2 = (const f32x4*)(P.out + (size_t)(has2 ? m2 : m) * DM) + lane;
        f32x4 v[4], w[4]; float s = 0.f, s2 = 0.f;
#pragma unroll
        for (int j = 0; j < 4; ++j) { v[j] = xr[64 * j]; w[j] = xr2[64 * j]; }
#pragma unroll
        for (int j = 0; j < 4; ++j) { s += (v[j].x * v[j].x + v[j].y * v[j].y) + (v[j].z * v[j].z + v[j].w * v[j].w); s2 += (w[j].x * w[j].x + w[j].y * w[j].y) + (w[j].z * w[j].z + w[j].w * w[j].w); }
        s = wave_sum(s); s2 = wave_sum(s2);
        const float r = 1.f / sqrtf(s * (1.f / DM) + EPS), r2 = 1.f / sqrtf(s2 * (1.f / DM) + EPS);
        f32x4* dr = (f32x4*)(dst + (size_t)m * DM) + lane;
#pragma unroll
        for (int j = 0; j < 4; ++j) dr[64 * j] = v[j] * r * g[j];
        if (has2) { f32x4* dr2 = (f32x4*)(dst + (size_t)m2 * DM) + lane;
#pragma unroll
            for (int j = 0; j < 4; ++j) dr2[64 * j] = w[j] * r2 * g[j]; }
    }
}

__device__ __forceinline__ void ml_chain(const Params& P, int l, int b, int h, LAS unsigned char* lds, int tid) {
    asm volatile("" : "+v"(tid));
    const int lane = tid & 63, wid = __builtin_amdgcn_readfirstlane(tid >> 6);
    LAS float* chs = (LAS float*)lds; const float* gates = (const float*)(P.ws + WS_GATES); float* mch = (float*)(P.ws + WS_MCH);
    const float ib = P.ml_i_bias[l * 4 + h], fb = P.ml_f_bias[l * 4 + h];
    for (int j = wid; j < 32; j += 8) { const size_t row = (size_t)b * SEQ + j * 64 + lane;
        const float li = gates[row * 8 + h] + ib, lf = logsigmoidf_(gates[row * 8 + 4 + h] + fb);
        const float bc = wave_incl_sum(lf); const float am = wave_incl_max(li - bc);
        if (lane == 63) { chs[2 * j] = bc; chs[2 * j + 1] = am; } }
    __syncthreads();
    if (tid == 0) { float m = 0.f; for (int j = 0; j < 32; ++j) { __hip_atomic_store(mch + (b * 4 + h) * 32 + j, m, __ATOMIC_RELAXED, __HIP_MEMORY_SCOPE_AGENT); m = chs[2 * j] + fmaxf(m, chs[2 * j + 1]); }
        __threadfence();
        __hip_atomic_store((unsigned*)(P.ws + WS_CTL) + 256 + l * 32 + b * 4 + h, 1u, __ATOMIC_RELEASE, __HIP_MEMORY_SCOPE_AGENT); }
    __syncthreads();
}
constexpr int MP_RQ = 0, MP_RK = 18240, MP_QS = 36480, MP_KS = 53888, MP_KT = 71296, MP_VT = 89728, MP_SC = 108160, MP_CW = 110016;
template <bool DRY> __device__ __forceinline__ void ml_pre(const Params& P, int l, int b, int h, int c, LAS unsigned char* lds, int tid) {
    asm volatile("" : "+v"(tid));
    const int lane = tid & 63, wid = __builtin_amdgcn_readfirstlane(tid >> 6), fr = lane & 15, fq = lane >> 4;
    LAS bf16* rawq = (LAS bf16*)(lds + MP_RQ); LAS bf16* rawk = (LAS bf16*)(lds + MP_RK); LAS bf16* qs = (LAS bf16*)(lds + MP_QS); LAS bf16* ks = (LAS bf16*)(lds + MP_KS);
    LAS bf16* kT = (LAS bf16*)(lds + MP_KT); LAS bf16* vT = (LAS bf16*)(lds + MP_VT);
    LAS float* chs = (LAS float*)(lds + MP_SC); LAS float* sc_a = chs + 64; LAS float* sc_M = sc_a + 64; LAS float* sc_inter = sc_a + 128; LAS float* sc_emt = sc_a + 192; LAS float* sc_wk = sc_a + 256; LAS float* rowsum = sc_a + 320;
    LAS float* cwq = (LAS float*)(lds + MP_CW); LAS float* cwk = cwq + 512; LAS float* cbq = cwq + 1024; LAS float* cbk = cwq + 1152;
    bf16* z = (bf16*)(P.ws + WS_BIG); const float* gates = (const float*)(P.ws + WS_GATES); const bf16* zhalo = (const bf16*)(P.ws + WS_ZHALO);
    bf16* mlw = (bf16*)(P.ws + WS_MLW); float* mls = (float*)(P.ws + WS_MLS);
    const int colq = 3072 + h * 128, colk = 3584 + h * 128, colv = 4096 + h * 128;
    const size_t rowb = (size_t)b * SEQ; const int t0 = c * 64; const int unit = (b * 4 + h) * 32 + c;
    const float ib = P.ml_i_bias[l * 4 + h], fb = P.ml_f_bias[l * 4 + h];
    { const float* w = P.ml_conv_w + (size_t)l * 4 * 1024; const float* bb = P.ml_conv_b + (size_t)l * 1024;
      const int j = tid >> 7, d = tid & 127; cwq[j * 128 + d] = w[j * 1024 + h * 128 + d]; cwk[j * 128 + d] = w[j * 1024 + 512 + h * 128 + d];
      if (tid < 128) { cbq[tid] = bb[h * 128 + tid]; cbk[tid] = bb[512 + h * 128 + tid]; }
      if (tid < 64) rowsum[tid] = 0.f; }
    { const int r = tid >> 3, c16 = (tid & 7) * 16; const bf16* zp = z + (rowb + t0 + r) * ZP;
      *(LAS v4u*)(rawq + (r + 3) * 136 + c16) = *(const v4u*)(zp + colq + c16); *(LAS v4u*)(rawq + (r + 3) * 136 + c16 + 8) = *(const v4u*)(zp + colq + c16 + 8);
      *(LAS v4u*)(rawk + (r + 3) * 136 + c16) = *(const v4u*)(zp + colk + c16); *(LAS v4u*)(rawk + (r + 3) * 136 + c16 + 8) = *(const v4u*)(zp + colk + c16 + 8);
      if (tid < 48) { const int hr = tid >> 4, pc = (tid & 15) * 8; v4u hq = (v4u){0u, 0u, 0u, 0u}, hk = hq;
          if (c > 0) { const bf16* hp = zhalo + ((size_t)(b * 32 + c - 1) * 3 + hr) * 1536 + h * 128 + pc; hq = *(const v4u*)(hp + 512); hk = *(const v4u*)(hp + 1024); }
          *(LAS v4u*)(rawq + hr * 136 + pc) = hq; *(LAS v4u*)(rawk + hr * 136 + pc) = hk; } }
    float pgi = 0.f, pgf = 0.f, m_run = 0.f;
    if (wid == 0) { const size_t row = rowb + t0 + lane; pgi = gates[row * 8 + h]; pgf = gates[row * 8 + 4 + h]; { unsigned* fl = (unsigned*)(P.ws + WS_CTL) + 256 + l * 32 + b * 4 + h; unsigned sp = 0;
            while (__hip_atomic_load(fl, __ATOMIC_RELAXED, __HIP_MEMORY_SCOPE_AGENT) == 0u && ++sp < (1u << 22)) __builtin_amdgcn_s_sleep(2);
            __builtin_amdgcn_fence(__ATOMIC_ACQUIRE, "agent"); }
          m_run = __hip_atomic_load((float*)(P.ws + WS_MCH) + (b * 4 + h) * 32 + c, __ATOMIC_RELAXED, __HIP_MEMORY_SCOPE_AGENT);
#if PROBE_SEL == 30
          { const int j_ = (int)(fabsf(m_run) * 1e-30f) & 31; const float m2_ = __hip_atomic_load((float*)(P.ws + WS_MCH) + (b * 4 + h) * 32 + j_, __ATOMIC_RELAXED, __HIP_MEMORY_SCOPE_AGENT); m_run += m2_ * 0.f; }
#endif
          }
    if (wid == 0) {
        const float li = pgi + ib, lf = logsigmoidf_(pgf + fb); const float bc = wave_incl_sum(lf);
        const float a = li - bc; const float cm = wave_incl_max(a);
        const float Mt = fmaxf(m_run, cm); const float M63 = __int_as_float(__builtin_amdgcn_readlane(__float_as_int(Mt), 63));
        const float inter = __expf(m_run - Mt), emt = __expf(-(bc + Mt));
        sc_a[lane] = a; sc_M[lane] = Mt; sc_inter[lane] = inter; sc_emt[lane] = emt; sc_wk[lane] = __expf(a - M63);
        mls[(size_t)unit * 256 + lane] = inter; mls[(size_t)unit * 256 + 64 + lane] = emt;
        if (lane == 0) mls[(size_t)unit * 256 + 192] = __expf(m_run - M63);
    }
    __syncthreads();
    {
        const int c16 = wid * 16; const float wkr = sc_wk[lane];
        float acc16[16];
#pragma unroll
        for (int i = 0; i < 16; ++i) acc16[i] = cbq[c16 + i];
#pragma unroll
        for (int j = 0; j < 4; ++j) { const v4u r0 = *(const LAS v4u*)(rawq + (lane + j) * 136 + c16), r1 = *(const LAS v4u*)(rawq + (lane + j) * 136 + c16 + 8);
            const unsigned w8[8] = {r0.x, r0.y, r0.z, r0.w, r1.x, r1.y, r1.z, r1.w};
#pragma unroll
            for (int i = 0; i < 8; ++i) { acc16[2 * i] += cwq[j * 128 + c16 + 2 * i] * bflo(w8[i]); acc16[2 * i + 1] += cwq[j * 128 + c16 + 2 * i + 1] * bfhi(w8[i]); } }
#pragma unroll
        for (int i = 0; i < 16; ++i) acc16[i] = acc16[i] * sigmoidf_(acc16[i]);
        v4u o;
        o.x = pk2(acc16[0], acc16[1]); o.y = pk2(acc16[2], acc16[3]); o.z = pk2(acc16[4], acc16[5]); o.w = pk2(acc16[6], acc16[7]); *(LAS v4u*)(qs + lane * 136 + c16) = o;
        o.x = pk2(acc16[8], acc16[9]); o.y = pk2(acc16[10], acc16[11]); o.z = pk2(acc16[12], acc16[13]); o.w = pk2(acc16[14], acc16[15]); *(LAS v4u*)(qs + lane * 136 + c16 + 8) = o;
#pragma unroll
        for (int i = 0; i < 16; ++i) acc16[i] = cbk[c16 + i];
#pragma unroll
        for (int j = 0; j < 4; ++j) { const v4u r0 = *(const LAS v4u*)(rawk + (lane + j) * 136 + c16), r1 = *(const LAS v4u*)(rawk + (lane + j) * 136 + c16 + 8);
            const unsigned w8[8] = {r0.x, r0.y, r0.z, r0.w, r1.x, r1.y, r1.z, r1.w};
#pragma unroll
            for (int i = 0; i < 8; ++i) { acc16[2 * i] += cwk[j * 128 + c16 + 2 * i] * bflo(w8[i]); acc16[2 * i + 1] += cwk[j * 128 + c16 + 2 * i + 1] * bfhi(w8[i]); } }
#pragma unroll
        for (int i = 0; i < 16; ++i) acc16[i] = acc16[i] * sigmoidf_(acc16[i]) * 0.08838834764831845f;
        o.x = pk2(acc16[0], acc16[1]); o.y = pk2(acc16[2], acc16[3]); o.z = pk2(acc16[4], acc16[5]); o.w = pk2(acc16[6], acc16[7]); *(LAS v4u*)(ks + lane * 136 + c16) = o;
        o.x = pk2(acc16[8], acc16[9]); o.y = pk2(acc16[10], acc16[11]); o.z = pk2(acc16[12], acc16[13]); o.w = pk2(acc16[14], acc16[15]); *(LAS v4u*)(ks + lane * 136 + c16 + 8) = o;
#pragma unroll
        for (int i = 0; i < 8; ++i) { const unsigned pw = pk2(acc16[2 * i] * wkr, acc16[2 * i + 1] * wkr); kT[(c16 + 2 * i) * 72 + lane] = (bf16)(pw & 0xffffu); kT[(c16 + 2 * i + 1) * 72 + lane] = (bf16)(pw >> 16); }
        const bf16* zp = z + (rowb + t0 + lane) * ZP + colv + c16;
        const v4u v0 = *(const v4u*)zp, v1 = *(const v4u*)(zp + 8);
        const unsigned vw[8] = {v0.x, v0.y, v0.z, v0.w, v1.x, v1.y, v1.z, v1.w};
#pragma unroll
        for (int i = 0; i < 8; ++i) { vT[(c16 + 2 * i) * 72 + lane] = (bf16)(vw[i] & 0xffffu); vT[(c16 + 2 * i + 1) * 72 + lane] = (bf16)(vw[i] >> 16); }
    }
    __syncthreads();
    {
        const int tt = wid >> 1, tq = 16 * tt + fr; const float Mt = sc_M[tq];
#pragma unroll
        for (int q2 = 0; q2 < 2; ++q2) {
            const int st = 2 * (wid & 1) + q2;
            v2u wv; wv.x = 0u; wv.y = 0u;
            if (st <= tt) {
                f32x4 acc = (f32x4){0.f, 0.f, 0.f, 0.f};
#pragma unroll
                for (int k4 = 0; k4 < 4; ++k4) { const bf16x8 a = *(const LAS bf16x8*)(ks + (16 * st + fr) * 136 + 32 * k4 + 8 * fq), bb = *(const LAS bf16x8*)(qs + tq * 136 + 32 * k4 + 8 * fq); acc = MFMA16(a, bb, acc); }
                const f32x4 av = *(const LAS f32x4*)(sc_a + 16 * st + 4 * fq);
                float w[4], rs = 0.f;
#pragma unroll
                for (int i = 0; i < 4; ++i) { const int s_ = 16 * st + 4 * fq + i; w[i] = (s_ <= tq) ? acc[i] * __expf(av[i] - Mt) : 0.f; rs += w[i]; }
                rs += __shfl_xor(rs, 16); rs += __shfl_xor(rs, 32);
                if (fq == 0) lds_addf(rowsum + tq, rs);
                wv.x = pk2(w[0], w[1]); wv.y = pk2(w[2], w[3]);
            }
            *(v2u*)(mlw + (size_t)unit * 4096 + tq * 64 + 16 * st + 4 * fq) = wv;
        }
        const int r = tid >> 3, c16 = (tid & 7) * 16; bf16* zp = z + (rowb + t0 + r) * ZP;
        if (!DRY) {
        *(v4u*)(zp + colq + c16) = *(const LAS v4u*)(qs + r * 136 + c16); *(v4u*)(zp + colq + c16 + 8) = *(const LAS v4u*)(qs + r * 136 + c16 + 8);
        const int d = 2 * r + (c16 >> 6), s0 = c16 & 63;
        *(v4u*)(zp + colk + c16) = *(const LAS v4u*)(kT + d * 72 + s0); *(v4u*)(zp + colk + c16 + 8) = *(const LAS v4u*)(kT + d * 72 + s0 + 8);
        *(v4u*)(zp + colv + c16) = *(const LAS v4u*)(vT + d * 72 + s0); *(v4u*)(zp + colv + c16 + 8) = *(const LAS v4u*)(vT + d * 72 + s0 + 8);
        { const int colo_ = 1536 + h * 128; const v4u o0 = *(const v4u*)(zp + colo_ + c16), o1 = *(const v4u*)(zp + colo_ + c16 + 8); const float* gp = P.ml_norm + l * 512 + h * 128 + c16;
          const unsigned ow8[8] = {o0.x, o0.y, o0.z, o0.w, o1.x, o1.y, o1.z, o1.w}; unsigned sg[8];
#pragma unroll
          for (int i = 0; i < 8; ++i) sg[i] = pk2(sigmoidf_(bflo(ow8[i])) * gp[2 * i], sigmoidf_(bfhi(ow8[i])) * gp[2 * i + 1]);
          *(v4u*)(zp + colo_ + c16) = (v4u){sg[0], sg[1], sg[2], sg[3]}; *(v4u*)(zp + colo_ + c16 + 8) = (v4u){sg[4], sg[5], sg[6], sg[7]}; }
        }
    }
    __syncthreads();
    if (tid < 64) mls[(size_t)unit * 256 + 128 + tid] = rowsum[tid];
    __syncthreads();
}
constexpr int MS_QS = 0, MS_KT = 17408, MS_VT = 35840, MS_W = 54272, MS_CT = 63488, MS_SC = 133120;
template <bool DRY> __device__ __forceinline__ void ml_seq(const Params& P, int l, int b, int h, LAS unsigned char* lds, int tid) {
    asm volatile("" : "+v"(tid));
    const int lane = tid & 63, wid = __builtin_amdgcn_readfirstlane(tid >> 6), fr = lane & 15, fq = lane >> 4;
    LAS bf16* qs = (LAS bf16*)(lds + MS_QS); LAS bf16* kT = (LAS bf16*)(lds + MS_KT); LAS bf16* vT = (LAS bf16*)(lds + MS_VT); LAS bf16* wsm = (LAS bf16*)(lds + MS_W); LAS bf16* CT0 = (LAS bf16*)(lds + MS_CT);
    LAS float* sc = (LAS float*)(lds + MS_SC);
    LAS float* qn = sc + 200; LAS float* ssq = sc + 264; LAS float* nvec = sc + 392; LAS float* gnl = sc + 520;
    bf16* z = (bf16*)(P.ws + WS_BIG); const bf16* mlw = (const bf16*)(P.ws + WS_MLW); const float* mls = (const float*)(P.ws + WS_MLS);
    const int colq = 3072 + h * 128, colk = 3584 + h * 128, colv = 4096 + h * 128, colo = 1536 + h * 128;
    const size_t rowb = (size_t)b * SEQ; const int unit0 = (b * 4 + h) * 32;
    if (tid < 128) { nvec[tid] = 0.f; gnl[tid] = P.ml_norm[l * 512 + h * 128 + tid]; ssq[tid] = 0.f; }
    for (int i = tid; i < 128 * 136 / 2; i += 512) ((LAS unsigned*)CT0)[i] = 0u;
    f32x4 Cacc[8];
#pragma unroll
    for (int i = 0; i < 8; ++i) Cacc[i] = (f32x4){0.f, 0.f, 0.f, 0.f};
    const int r = tid >> 3, c16 = (tid & 7) * 16;
    const int tt = wid >> 1, tq = 16 * tt + fr;
    v4u pq[2], pkt[2], pvt[2], pw; float ps = 0.f;
    v2u ow[4]; f32x4 hv[4];
#pragma unroll
    for (int i = 0; i < 4; ++i) { hv[i] = (f32x4){0.f, 0.f, 0.f, 0.f}; ow[i] = (v2u){0u, 0u}; }
#define MS_LOAD(CH) do { const bf16* zp = z + (rowb + (CH) * 64 + r) * ZP; \
        pq[0] = *(const v4u*)(zp + colq + c16); pq[1] = *(const v4u*)(zp + colq + c16 + 8); pkt[0] = *(const v4u*)(zp + colk + c16); pkt[1] = *(const v4u*)(zp + colk + c16 + 8); \
        pvt[0] = *(const v4u*)(zp + colv + c16); pvt[1] = *(const v4u*)(zp + colv + c16 + 8); pw = *(const v4u*)(mlw + (size_t)(unit0 + (CH)) * 4096 + tid * 8); \
        if (tid < 193) ps = mls[(size_t)(unit0 + (CH)) * 256 + tid]; } while (0)
#define MS_EMIT(CH) do { const float rn = 1.f / sqrtf(ssq[((CH) & 1) * 64 + tq] * (1.f / 128.f) + EPS); \
        bf16* zp = z + (rowb + (CH) * 64 + tq) * ZP + colo; \
        _Pragma("unroll") for (int q4 = 0; q4 < 4; ++q4) { const int e0 = 16 * (4 * (wid & 1) + q4) + 4 * fq; \
            const float y0 = hv[q4].x * rn * bflo(ow[q4].x), y1 = hv[q4].y * rn * bfhi(ow[q4].x); \
            const float y2 = hv[q4].z * rn * bflo(ow[q4].y), y3 = hv[q4].w * rn * bfhi(ow[q4].y); \
            v2u yo; yo.x = pk2(y0, y1); yo.y = pk2(y2, y3); if (DRY) yo = ow[q4]; *(v2u*)(zp + e0) = yo; } } while (0)
    MS_LOAD(0);
    __syncthreads();
    for (int ch = 0; ch < 32; ++ch) {
        const int t0 = ch * 64; const int par = ch & 1;
        LAS bf16* CTr = CT0 + par * (128 * 136); LAS bf16* CTw = CT0 + (par ^ 1) * (128 * 136);
        if (ch > 0) MS_EMIT(ch - 1);
        {
            *(LAS v4u*)(qs + r * 136 + c16) = pq[0]; *(LAS v4u*)(qs + r * 136 + c16 + 8) = pq[1];
            const int d = 2 * r + (c16 >> 6), s0 = c16 & 63;
            *(LAS v4u*)(kT + d * 72 + s0) = pkt[0]; *(LAS v4u*)(kT + d * 72 + s0 + 8) = pkt[1];
            *(LAS v4u*)(vT + d * 72 + s0) = pvt[0]; *(LAS v4u*)(vT + d * 72 + s0 + 8) = pvt[1];
            *(LAS v4u*)(wsm + r * 72 + (tid & 7) * 8) = pw;
            if (tid < 193) sc[tid] = ps;
            if (tid >= 256 && tid < 320) ssq[par * 64 + tid - 256] = 0.f;
            const unsigned qw[8] = {pq[0].x, pq[0].y, pq[0].z, pq[0].w, pq[1].x, pq[1].y, pq[1].z, pq[1].w};
            float qnp = 0.f;
#pragma unroll
            for (int i = 0; i < 8; ++i) qnp += bflo(qw[i]) * nvec[c16 + 2 * i] + bfhi(qw[i]) * nvec[c16 + 2 * i + 1];
            qnp += __shfl_xor(qnp, 1); qnp += __shfl_xor(qnp, 2); qnp += __shfl_xor(qnp, 4);
            if ((tid & 7) == 0) qn[r] = qnp;
        }
        if (ch + 1 < 32) MS_LOAD(ch + 1);
        { const bf16* zp = z + (rowb + t0 + tq) * ZP + colo;
#pragma unroll
          for (int q4 = 0; q4 < 4; ++q4) ow[q4] = *(const v2u*)(zp + 16 * (4 * (wid & 1) + q4) + 4 * fq); }
        __syncthreads();
        {
            const float inter = sc[tq];
            const float den = inter * qn[tq] + sc[128 + tq];
            const float scl = __builtin_amdgcn_rcpf(fmaxf(fabsf(den), sc[64 + tq]));
            float ss = 0.f;
            bf16x8 qf[4], wf[2];
#pragma unroll
            for (int k4 = 0; k4 < 4; ++k4) qf[k4] = *(const LAS bf16x8*)(qs + tq * 136 + 32 * k4 + 8 * fq);
#pragma unroll
            for (int k2 = 0; k2 < 2; ++k2) wf[k2] = *(const LAS bf16x8*)(wsm + tq * 72 + 32 * k2 + 8 * fq);
            bf16x8 cf[4][4], vfr[4][2];
#pragma unroll
            for (int q4 = 0; q4 < 4; ++q4) { const int et = 4 * (wid & 1) + q4;
#pragma unroll
                for (int k4 = 0; k4 < 4; ++k4) cf[q4][k4] = *(const LAS bf16x8*)(CTr + (16 * et + fr) * 136 + 32 * k4 + 8 * fq);
#pragma unroll
                for (int k2 = 0; k2 < 2; ++k2) vfr[q4][k2] = *(const LAS bf16x8*)(vT + (16 * et + fr) * 72 + 32 * k2 + 8 * fq); }
            f32x4 acc4[4];
#pragma unroll
            for (int q4 = 0; q4 < 4; ++q4) acc4[q4] = (f32x4){0.f, 0.f, 0.f, 0.f};
#pragma unroll
            for (int k4 = 0; k4 < 4; ++k4)
#pragma unroll
                for (int q4 = 0; q4 < 4; ++q4) acc4[q4] = MFMA16(cf[q4][k4], qf[k4], acc4[q4]);
#pragma unroll
            for (int q4 = 0; q4 < 4; ++q4) acc4[q4] = acc4[q4] * inter;
#pragma unroll
            for (int k2 = 0; k2 < 2; ++k2)
#pragma unroll
                for (int q4 = 0; q4 < 4; ++q4) acc4[q4] = MFMA16(vfr[q4][k2], wf[k2], acc4[q4]);
#pragma unroll
            for (int q4 = 0; q4 < 4; ++q4) { hv[q4] = acc4[q4] * scl; ss += (hv[q4].x * hv[q4].x + hv[q4].y * hv[q4].y) + (hv[q4].z * hv[q4].z + hv[q4].w * hv[q4].w); }
            ss += __shfl_xor(ss, 16); ss += __shfl_xor(ss, 32);
            if (fq == 0) lds_addf(ssq + par * 64 + tq, ss);
        }
        {
            const float decay = sc[192];
            bf16x8 vf[2];
#pragma unroll
            for (int k2 = 0; k2 < 2; ++k2) vf[k2] = *(const LAS bf16x8*)(vT + (16 * wid + fr) * 72 + 32 * k2 + 8 * fq);
            bf16x8 kf[8][2];
#pragma unroll
            for (int dt = 0; dt < 8; ++dt)
#pragma unroll
                for (int k2 = 0; k2 < 2; ++k2) kf[dt][k2] = *(const LAS bf16x8*)(kT + (16 * dt + fr) * 72 + 32 * k2 + 8 * fq);
#pragma unroll
            for (int dt = 0; dt < 8; ++dt) Cacc[dt] = Cacc[dt] * decay;
#pragma unroll
            for (int k2 = 0; k2 < 2; ++k2)
#pragma unroll
                for (int dt = 0; dt < 8; ++dt) Cacc[dt] = MFMA16(kf[dt][k2], vf[k2], Cacc[dt]);
#pragma unroll
            for (int dt = 0; dt < 8; ++dt) { v2u cw; cw.x = pk2(Cacc[dt].x, Cacc[dt].y); cw.y = pk2(Cacc[dt].z, Cacc[dt].w);
                *(LAS v2u*)(CTw + (16 * wid + fr) * 136 + 16 * dt + 4 * fq) = cw; }
            { const int d = tid >> 2, qd = tid & 3; float s_ = 0.f;
#pragma unroll
                for (int j = 0; j < 2; ++j) { const v4u kk = *(const LAS v4u*)(kT + d * 72 + 16 * qd + 8 * j); s_ += (bflo(kk.x) + bfhi(kk.x)) + (bflo(kk.y) + bfhi(kk.y)) + (bflo(kk.z) + bfhi(kk.z)) + (bflo(kk.w) + bfhi(kk.w)); }
                s_ += __shfl_xor(s_, 1); s_ += __shfl_xor(s_, 2);
                if (qd == 0) nvec[d] = decay * nvec[d] + s_; }
        }
        __syncthreads();
    }
    MS_EMIT(31);
#undef MS_LOAD
#undef MS_EMIT
}
constexpr int RP_RX = 0, RP_US = 18240, RP_A = 35648, RP_B = 35648 + 33792, RP_CW = 35648 + 2 * 33792, RP_P = 132;
template <bool DRY> __device__ __forceinline__ void rg_pre(const Params& P, int l, int b, int n, int cgp, LAS unsigned char* lds, int tid) {
    asm volatile("" : "+v"(tid));
    const int lane = tid & 63, wid = __builtin_amdgcn_readfirstlane(tid >> 6), fr = lane & 15, fq = lane >> 4;
    LAS bf16* rawx = (LAS bf16*)(lds + RP_RX); LAS bf16* us = (LAS bf16*)(lds + RP_US); LAS float* a_s = (LAS float*)(lds + RP_A); LAS float* b_s = (LAS float*)(lds + RP_B); LAS float* cw = (LAS float*)(lds + RP_CW); LAS float* cb = cw + 512;
    bf16* z = (bf16*)(P.ws + WS_BIG); const bf16* zhalo = (const bf16*)(P.ws + WS_ZHALO); bf16* rga = (bf16*)(P.ws + WS_RGA); float* rgsum = (float*)(P.ws + WS_RGSUM);
    const int colx = n * 128; const size_t rowb = (size_t)b * SEQ;
    { const float* w = P.rg_conv_w + (size_t)l * 4 * 512; const int j = tid >> 7, d = tid & 127; cw[j * 128 + d] = w[j * 512 + n * 128 + d]; if (tid < 128) cb[tid] = P.rg_conv_b[l * 512 + n * 128 + tid]; }
    bf16x8 Wr[4], Wi[4];
    { const float* wa = P.rg_wa + ((size_t)l * 4 + n) * 16384; const float* wx = P.rg_wx + ((size_t)l * 4 + n) * 16384; const int j = 16 * wid + fr;
#pragma unroll
      for (int k4 = 0; k4 < 4; ++k4) {
          unsigned pr[4], pi[4];
#pragma unroll
          for (int x2 = 0; x2 < 4; ++x2) { const int i0 = 32 * k4 + 8 * fq + 2 * x2; pr[x2] = pk2(wa[i0 * 128 + j], wa[(i0 + 1) * 128 + j]); pi[x2] = pk2(wx[i0 * 128 + j], wx[(i0 + 1) * 128 + j]); }
          Wr[k4] = __builtin_bit_cast(bf16x8, (v4u){pr[0], pr[1], pr[2], pr[3]}); Wi[k4] = __builtin_bit_cast(bf16x8, (v4u){pi[0], pi[1], pi[2], pi[3]}); } }
    float ba[4], bx[4], lsl[4];
#pragma unroll
    for (int i = 0; i < 4; ++i) { const int cc = l * 512 + n * 128 + 16 * wid + 4 * fq + i; ba[i] = P.rg_ba[cc]; bx[i] = P.rg_bx[cc]; lsl[i] = 8.f * logsigmoidf_(P.rg_lambda[cc]); }
    const int r = tid >> 3, c16r = (tid & 7) * 16;
    v4u px0, px1, phx = (v4u){0u, 0u, 0u, 0u};
#define RP_LOAD(C) do { const bf16* zp = z + (rowb + (C) * 64 + r) * ZP + colx + c16r; px0 = *(const v4u*)zp; px1 = *(const v4u*)(zp + 8); phx = (v4u){0u, 0u, 0u, 0u}; \
        if (tid < 48 && (C) > 0) phx = *(const v4u*)(zhalo + ((size_t)(b * 32 + (C) - 1) * 3 + (tid >> 4)) * 1536 + n * 128 + (tid & 15) * 8); } while (0)
    RP_LOAD(cgp * 4);
    for (int ci = 0; ci < 4; ++ci) {
        const int c = cgp * 4 + ci, t0 = c * 64;
        *(LAS v4u*)(rawx + (r + 3) * 136 + c16r) = px0; *(LAS v4u*)(rawx + (r + 3) * 136 + c16r + 8) = px1;
        if (tid < 48) *(LAS v4u*)(rawx + (tid >> 4) * 136 + (tid & 15) * 8) = phx;
        if (ci + 1 < 4) RP_LOAD(c + 1);
        __syncthreads();
        { const int c16 = wid * 16; float au[16];
#pragma unroll
          for (int i = 0; i < 16; ++i) au[i] = cb[c16 + i];
#pragma unroll
          for (int j = 0; j < 4; ++j) { const v4u r0 = *(const LAS v4u*)(rawx + (lane + j) * 136 + c16), r1 = *(const LAS v4u*)(rawx + (lane + j) * 136 + c16 + 8);
              const unsigned xw[8] = {r0.x, r0.y, r0.z, r0.w, r1.x, r1.y, r1.z, r1.w};
#pragma unroll
              for (int i = 0; i < 8; ++i) { au[2 * i] += cw[j * 128 + c16 + 2 * i] * bflo(xw[i]); au[2 * i + 1] += cw[j * 128 + c16 + 2 * i + 1] * bfhi(xw[i]); } }
          v4u o;
          o.x = pk2(au[0], au[1]); o.y = pk2(au[2], au[3]); o.z = pk2(au[4], au[5]); o.w = pk2(au[6], au[7]); *(LAS v4u*)(us + lane * 136 + c16) = o;
          o.x = pk2(au[8], au[9]); o.y = pk2(au[10], au[11]); o.z = pk2(au[12], au[13]); o.w = pk2(au[14], au[15]); *(LAS v4u*)(us + lane * 136 + c16 + 8) = o; }
        __syncthreads();
#if PROBE_SEL == 24
        if (!DRY)
#endif
#pragma unroll
        for (int tt = 0; tt < 4; ++tt) {
            f32x4 ar = (f32x4){0.f, 0.f, 0.f, 0.f}, ai = (f32x4){0.f, 0.f, 0.f, 0.f};
#pragma unroll
            for (int k4 = 0; k4 < 4; ++k4) { const bf16x8 bb = *(const LAS bf16x8*)(us + (16 * tt + fr) * 136 + 32 * k4 + 8 * fq); ar = MFMA16(Wr[k4], bb, ar); ai = MFMA16(Wi[k4], bb, ai); }
            const int t = 16 * tt + fr, c0 = 16 * wid + 4 * fq;
            const v2u uw = *(const LAS v2u*)(us + t * 136 + c0);
            const float uu[4] = {bflo(uw.x), bfhi(uw.x), bflo(uw.y), bfhi(uw.y)};
            f32x4 av, bv;
#pragma unroll
            for (int i = 0; i < 4; ++i) { const float rr = sigmoidf_(ar[i] + ba[i]), ii = sigmoidf_(ai[i] + bx[i]); const float la = rr * lsl[i]; av[i] = __expf(la);
                const float x2 = 2.f * la; const float poly = -x2 * (1.f + x2 * (0.5f + x2 * (0.16666667f + x2 * (0.041666668f + x2 * 0.0083333338f))));
                const float om = (x2 < -0.25f) ? 1.f - __expf(x2) : poly;
                bv[i] = __builtin_amdgcn_sqrtf(fmaxf(om, 0.f)) * ii * uu[i]; }
            *(LAS f32x4*)(a_s + t * RP_P + c0) = av; *(LAS f32x4*)(b_s + t * RP_P + c0) = bv;
        }
        __syncthreads();
        { const int chn = tid & 127, qt = tid >> 7; LAS float* qsum = cw + 640;
          float hc = 0.f, ap = 1.f;
#pragma unroll
          for (int t = 0; t < 16; ++t) { const int tt_ = qt * 16 + t; const float a = a_s[tt_ * RP_P + chn]; hc = a * hc + b_s[tt_ * RP_P + chn]; ap *= a; b_s[tt_ * RP_P + chn] = hc; a_s[tt_ * RP_P + chn] = ap; }
          qsum[(qt * 128 + chn) * 2] = ap; qsum[(qt * 128 + chn) * 2 + 1] = hc;
          __syncthreads();
          float hin_ = 0.f, ain_ = 1.f;
#pragma unroll
          for (int q = 0; q < 3; ++q) if (q < qt) { const float aq = qsum[(q * 128 + chn) * 2], hq = qsum[(q * 128 + chn) * 2 + 1]; hin_ = aq * hin_ + hq; ain_ *= aq; }
          if (qt > 0) {
#pragma unroll
              for (int t = 0; t < 16; ++t) { const int tt_ = qt * 16 + t; const float al = a_s[tt_ * RP_P + chn]; b_s[tt_ * RP_P + chn] += al * hin_; a_s[tt_ * RP_P + chn] = al * ain_; } }
          if (qt == 3) { float* sp = rgsum + ((size_t)(b * 32 + c) * 512 + n * 128 + chn) * 2; sp[0] = ap * ain_; sp[1] = hc + ap * hin_; } }
        __syncthreads();
        { const size_t row = rowb + t0 + r; float hl[16], apv[16];
#pragma unroll
          for (int i = 0; i < 4; ++i) { const f32x4 x = *(const LAS f32x4*)(b_s + r * RP_P + c16r + 4 * i), y = *(const LAS f32x4*)(a_s + r * RP_P + c16r + 4 * i);
              hl[4 * i] = x.x; hl[4 * i + 1] = x.y; hl[4 * i + 2] = x.z; hl[4 * i + 3] = x.w; apv[4 * i] = y.x; apv[4 * i + 1] = y.y; apv[4 * i + 2] = y.z; apv[4 * i + 3] = y.w; }
          v4u o;
          o.x = pk2(hl[0], hl[1]); o.y = pk2(hl[2], hl[3]); o.z = pk2(hl[4], hl[5]); o.w = pk2(hl[6], hl[7]); if (!DRY) *(v4u*)(z + row * ZP + colx + c16r) = o;
          o.x = pk2(hl[8], hl[9]); o.y = pk2(hl[10], hl[11]); o.z = pk2(hl[12], hl[13]); o.w = pk2(hl[14], hl[15]); if (!DRY) *(v4u*)(z + row * ZP + colx + c16r + 8) = o;
          o.x = pk2(apv[0], apv[1]); o.y = pk2(apv[2], apv[3]); o.z = pk2(apv[4], apv[5]); o.w = pk2(apv[6], apv[7]); *(v4u*)(rga + row * 512 + colx + c16r) = o;
          o.x = pk2(apv[8], apv[9]); o.y = pk2(apv[10], apv[11]); o.z = pk2(apv[12], apv[13]); o.w = pk2(apv[14], apv[15]); *(v4u*)(rga + row * 512 + colx + c16r + 8) = o; }
        __syncthreads();
    }
}
__device__ __forceinline__ void rg_scan(const Params& P, int b, int n, int tid) {
    asm volatile("" : "+v"(tid));
    if (tid < 128) {
        const float* rgsum = (const float*)(P.ws + WS_RGSUM); float* hin = (float*)(P.ws + WS_RGHIN);
        const int ch = n * 128 + tid; float h = 0.f;
        typedef float f32x2v_ __attribute__((ext_vector_type(2)));
        f32x2v_ sv[32];
#pragma unroll
        for (int c = 0; c < 32; ++c) sv[c] = *(const f32x2v_*)(rgsum + ((size_t)(b * 32 + c) * 512 + ch) * 2);
#pragma unroll
        for (int c = 0; c < 32; ++c) { hin[(size_t)(b * 32 + c) * 512 + ch] = h; h = sv[c].x * h + sv[c].y; }
    }
}

__global__ void __launch_bounds__(NWAVES * 64, 2) fwd_megakernel(Params P) {
    extern __shared__ __attribute__((aligned(16))) unsigned char lds_raw[];
    cg::grid_group grid = cg::this_grid();
    LAS unsigned char* lds = (LAS unsigned char*)lds_raw;
    volatile LAS unsigned* MISC = (volatile LAS unsigned*)(lds + MISC_OFF);
    if (threadIdx.x < 64) MISC[threadIdx.x] = 0u;
    __syncthreads();
    (void)xcd_barrier_post((unsigned*)(P.ws + WS_CTL) + 1024, MISC + 8);
#define SEAM() do { XcdBarrier xb_; xb_.bar = (unsigned*)(P.ws + WS_CTL) + 1024; xb_.x = xb_xcc_id(); xb_.st = (volatile LAS unsigned*)(lds + MISC_OFF) + 8; xcd_barrier(xb_); } while (0)
    const int G = gridDim.x, NGW = G * NWAVES;
#define FRESH() int tid = threadIdx.x; asm volatile("" : "+v"(tid)); const int lane = tid & 63, wave = __builtin_amdgcn_readfirstlane(tid >> 6), gw = blockIdx.x * NWAVES + wave; (void)lane; (void)gw
    unsigned char* ws = P.ws;
    unsigned* ctl = (unsigned*)(ws + WS_CTL);
    float* rstd = (float*)(ws + WS_RSTD); float* rgss = (float*)(ws + WS_RGSS); float* ssa = (float*)(ws + WS_SSA); (void)rstd; float* gates = (float*)(ws + WS_GATES); float* rope = (float*)(ws + WS_ROPE);
    bf16* xb = (bf16*)(ws + WS_XB); bf16* zb = (bf16*)(ws + WS_BIG);

#pragma unroll 1
    for (int l = 0; l < DEPTH; ++l) {
        const float* xin = (l == 0) ? P.x : P.out;
        if (l == 0) {
          { FRESH();
            convert_weights<0>(P, l, lds, gw, NGW, wave, lane);
            for (int i0 = 0; i0 < M * 8; i0 += G * 512) { const int i = i0 + blockIdx.x * 512 + tid; if (i >= M * 8) break; const int row = i >> 3, j = i & 7;
                const float inv = powf(500000.f, -(float)j * 0.125f); const float ang = (float)P.pos[row] * inv; float sn, cs; sincosf(ang, &sn, &cs);
                rope[(size_t)row * 16 + j] = cs; rope[(size_t)row * 16 + 8 + j] = sn; }
            rowpass<false>(xin, xb, ssa, nullptr, nullptr, gw, NGW, lane); }
          grid.sync();
        }
        { pg8::Gemm g{xb, (const bf16*)(ws + WS_WIN), M, ZP + 256, DM, DM}; pg8::StaticOrder S; S.init(M, ZP + 256, G, (int)blockIdx.x);
          pg8::EpiZ E{zb, ssa, rope, (bf16*)(ws + WS_ZHALO), gates};
#ifndef NO_G1
          pg8::gemm_phase<pg8::EpiZ, pg8::StaticOrder, true, true>(lds, g, S, E);
#if PROBE_SEL == 1
          pg8::gemm_phase<pg8::EpiZ, pg8::StaticOrder, true, true>(lds, g, S, E);
#endif
#endif
        }
        SEAM();
        {
            FRESH();
            for (int i0 = 0; i0 < M; i0 += G * 512) { const int i = i0 + blockIdx.x * 512 + tid; if (i < M) { rgss[i] = 0.f; ssa[i] = 0.f; } }
            for (int bh = (int)blockIdx.x; bh < 32; bh += G) ml_chain(P, l, bh >> 2, bh & 3, lds, tid);
            unsigned* cpre = ctl + l * 128 + 32;
#if PROBE_SEL == 21 || PROBE_SEL == 22 || PROBE_SEL == 23 || PROBE_SEL == 24 || PROBE_SEL == 25
            { unsigned* c2 = ctl + l * 128 + 100;
              for (;;) {
                if (tid == 0) MISC[0] = atomicAdd(c2, 1u);
                __syncthreads(); const unsigned u = MISC[0]; __syncthreads();
                if (u >= 1280u) break;
#if PROBE_SEL != 23
                if (u < 256u) rg_pre<true>(P, l, (int)(u >> 5), (int)((u >> 3) & 3), (int)(u & 7), lds, tid);
#endif
#if PROBE_SEL != 22 && PROBE_SEL != 24 && PROBE_SEL != 25
                if (u >= 256u) { const unsigned v = u - 256u; ml_pre<true>(P, l, (int)(v >> 7), (int)((v >> 5) & 3), (int)(v & 31), lds, tid); }
#endif
              }
              SEAM(); }
#endif
            for (;;) {
                if (tid == 0) MISC[0] = atomicAdd(cpre, 1u);
                __syncthreads(); const unsigned u = MISC[0]; __syncthreads();
                if (u >= 1280u) break;
                if (u < 256u) rg_pre<false>(P, l, (int)(u >> 5), (int)((u >> 3) & 3), (int)(u & 7), lds, tid);
                else { const unsigned v = u - 256u; ml_pre<false>(P, l, (int)(v >> 7), (int)((v >> 5) & 3), (int)(v & 31), lds, tid); }
            }
        }
        SEAM();
        {
            FRESH();
            unsigned* cseq = ctl + l * 128, *catt = ctl + l * 128 + 64;
#if PROBE_SEL == 20
            { unsigned* c2 = ctl + l * 128 + 96;
              for (;;) {
                if (tid == 0) MISC[0] = atomicAdd(c2, 1u);
                __syncthreads(); const unsigned u = MISC[0]; __syncthreads();
                if (u >= 32u) break;
                ml_seq<true>(P, l, (int)(u >> 2), (int)(u & 3), lds, tid); __syncthreads();
              }
              SEAM(); }
#endif
            for (unsigned u = blockIdx.x; u < 64u; u += (unsigned)G) {
                if (u < 32u) ml_seq<false>(P, l, (int)(u >> 2), (int)(u & 3), lds, tid); else rg_scan(P, (int)((u - 32) >> 2), (int)((u - 32) & 3), tid);
                __syncthreads();
            }
            (void)cseq;
            for (;;) {
                if (tid == 0) MISC[0] = atomicAdd(catt, 1u);
                __syncthreads(); const unsigned u = MISC[0]; __syncthreads();
                if (u >= 1024u) break;
                const int qb = 7 - (int)(u >> 7), rem = (int)(u & 127), b = rem >> 4, vh = rem & 15, hc = vh >> 1, e = vh & 1, hh = vh >> 2;
                attn_body::attn_unit<8>(b, qb, (const attn_body::bf16*)(zb + 1024 + hc * 64), (const attn_body::bf16*)(zb + 2048 + hc * 64), (const attn_body::bf16*)(zb + 2560 + hh * 128 + e * 64),
                                        (attn_body::bf16*)(xb + vh * 64), (char*)lds_raw);
            }
            { unsigned* ccv = ctl + l * 128 + 48;
              for (;;) {
                if (tid == 0) MISC[0] = atomicAdd(ccv, 1u);
                __syncthreads(); const unsigned u = MISC[0]; __syncthreads();
                if (u >= 624u) break;
                convert_weights<1>(P, l, lds, (int)u * NWAVES + wave, 1 << 30, wave, lane);
                __syncthreads();
              } }
        }
        SEAM();
        { FRESH(); finalize_mixers(P, l, gw, NGW, lane); }
        SEAM();
#if PROBE_SEL == 5
        for (int i = 0; i < 10; ++i) SEAM();
#endif
        { pg8::Gemm g{zb + 512, (const bf16*)(ws + WS_WOUT), M, DM, DMIX, ZP}; pg8::StaticOrder S; S.init(M, DM, G, (int)blockIdx.x);
          pg8::EpiResN E{xin, P.out, xb, rgss};
          pg8::gemm_phase<pg8::EpiResN, pg8::StaticOrder, true, true>(lds, g, S, E); }
        SEAM();
        { pg8::Gemm g{xb, (const bf16*)(ws + WS_WUP), M, UP, DM, DM}; pg8::StaticOrder S; S.init(M, UP, G, (int)blockIdx.x);
          pg8::EpiUG E{zb, rgss, (bf16*)(ws + WS_HALO), (bf16*)(ws + WS_UHEAD), P.ffn_conv_w + (size_t)l * 3 * UP, P.ffn_conv_b + (size_t)l * UP};
#ifndef NO_G4
          pg8::gemm_phase<pg8::EpiUG, pg8::StaticOrder, true, true>(lds, g, S, E);
#if PROBE_SEL == 2
          pg8::gemm_phase<pg8::EpiUG, pg8::StaticOrder, true, true>(lds, g, S, E);
#endif
#endif
          if (l + 1 < DEPTH) { FRESH();
              if (G == 256) { if (blockIdx.x >= 128) convert_weights<0>(P, l + 1, lds, ((int)blockIdx.x - 128) * NWAVES + wave, 128 * NWAVES, wave, lane); }
              else convert_weights<0>(P, l + 1, lds, gw, NGW, wave, lane); }
        }
        SEAM();
#ifndef NO_CG
        { FRESH(); conv_gate(P, l, tid, (int)blockIdx.x, 256, G); }
#endif
        SEAM();
        { pg8::Gemm g{zb, (const bf16*)(ws + WS_WDN), M, DM, DFF, DFF}; pg8::StaticOrder S; S.init(M, DM, G, (int)blockIdx.x);
          if (l + 1 < DEPTH) { pg8::EpiResN E{P.out, P.out, xb, ssa};
              pg8::gemm_phase<pg8::EpiResN, pg8::StaticOrder, true, true>(lds, g, S, E); }
          else { pg8::EpiResL E{P.out, P.out, xb, ssa};
              pg8::gemm_phase<pg8::EpiResL, pg8::StaticOrder, true, true>(lds, g, S, E); }
        }
        SEAM();
    }
    { FRESH(); final_norm(P, gw, NGW, lane, P.out); }
}

extern "C" void kernel_launch(void* const* d_in, const int* in_sizes, int n_in, void* d_out, int out_size, void* d_ws, size_t ws_size, hipStream_t stream) {
    static int grid_blocks = 0;
    if (grid_blocks == 0) {
        if (n_in != 26 || out_size != M * DM || ws_size < WS_END) { fprintf(stderr, "kernel_launch: unexpected shapes (n_in %d out %d ws %zu)\n", n_in, out_size, ws_size); grid_blocks = -1; return; }
        int dev = 0, cus = 0, per_cu = 0;
        hipGetDevice(&dev); hipDeviceGetAttribute(&cus, hipDeviceAttributeMultiprocessorCount, dev);
        if (hipFuncSetAttribute((const void*)fwd_megakernel, hipFuncAttributeMaxDynamicSharedMemorySize, LDS_BYTES) != hipSuccess) { fprintf(stderr, "kernel_launch: hipFuncSetAttribute failed\n"); grid_blocks = -1; return; }
        if (hipOccupancyMaxActiveBlocksPerMultiprocessor(&per_cu, (const void*)fwd_megakernel, NWAVES * 64, LDS_BYTES) != hipSuccess || per_cu < 1) { fprintf(stderr, "kernel_launch: occupancy query says %d\n", per_cu); per_cu = 1; (void)hipGetLastError(); }
        grid_blocks = cus * 1;
    }
    if (grid_blocks < 0) return;
    hipMemsetAsync((char*)d_ws + WS_CTL, 0, 32768, stream);
    Params p{};
    const void** pp = (const void**)&p;
    for (int i = 0; i < 26; ++i) pp[i] = d_in[i];
    p.out = (float*)d_out; p.ws = (unsigned char*)d_ws;
    void* args[] = {&p};
    hipError_t e = hipLaunchCooperativeKernel((const void*)fwd_megakernel, dim3(grid_blocks), dim3(NWAVES * 64), args, LDS_BYTES, stream);
    if (e != hipSuccess) fprintf(stderr, "cooperative launch failed: %s (grid %d)\n", hipGetErrorString(e), grid_blocks);
}
```
